# Optimizing an MI355X kernel written in HIP

```python
import jax, jax.numpy as jnp
from jax import lax
import numpy as np

D_MODEL = 2048
BATCH = 1
SEQ = 16384
DEPTH = 4
DEC_BATCH = 8
DEC_SEQ = 64
PAST_LEN = 4096

CHUNK = 64
D_MIX = D_MODEL
GLA_WIDTH = D_MIX // 2
GLA_HEADS = 4
GLA_DV = GLA_WIDTH // GLA_HEADS
GLA_DK = GLA_DV // 2
GLA_KEY_WIDTH = GLA_HEADS * GLA_DK
GATE_RANK = 16
GATE_TEMP = 16.0
MLP_WIDTH = D_MIX - GLA_WIDTH
MLP_GROUPS = 4
MLP_GC = MLP_WIDTH // MLP_GROUPS
MLP_CHUNK = 128
D_IN = 2 * GLA_KEY_WIDTH + 2 * GLA_WIDTH + GATE_RANK + 3 * MLP_WIDTH
EPS = 1e-6

kernel_name = "hymba_gla_gmlp_streaming_step"


def rmsnorm(x, g):
    xf = x.astype(jnp.float32)
    y = xf * lax.rsqrt(jnp.mean(xf * xf, axis=-1, keepdims=True) + EPS)
    return (y * g.astype(jnp.float32)).astype(x.dtype)


def layernorm(x, g, b):
    xf = x.astype(jnp.float32)
    mu = jnp.mean(xf, axis=-1, keepdims=True)
    xc = xf - mu
    y = xc * lax.rsqrt(jnp.mean(xc * xc, axis=-1, keepdims=True) + EPS)
    return (y * g.astype(jnp.float32) + b.astype(jnp.float32)).astype(x.dtype)


def split_projection(z):
    sizes = [GLA_KEY_WIDTH, GLA_KEY_WIDTH, GLA_WIDTH, GLA_WIDTH, GATE_RANK, MLP_WIDTH, MLP_WIDTH, MLP_WIDTH]
    outs, off = [], 0
    for s in sizes:
        outs.append(z[..., off:off + s])
        off += s
    return outs


def gla_scan(q, k, v, log_a, s0, blk):
    B, L, H, _ = q.shape
    n = L // blk

    def to_blocks(t):
        return t.astype(jnp.float32).reshape(B, n, blk, H, t.shape[-1]).transpose(1, 0, 3, 2, 4)

    causal = jnp.tril(jnp.ones((blk, blk), dtype=bool))[:, :, None]

    def step(S, inp):
        qb, kb, vb, gb = inp
        b = jnp.cumsum(gb, axis=-2)
        diff = b[..., :, None, :] - b[..., None, :, :]
        decay = jnp.where(causal, jnp.exp(jnp.where(causal, diff, 0.0)), 0.0)
        scores = jnp.einsum('bhtd,bhsd,bhtsd->bhts', qb, kb, decay)
        o = (jnp.einsum('bhts,bhsv->bhtv', scores, vb)
             + jnp.einsum('bhtd,bhdv->bhtv', qb * jnp.exp(b), S))
        b_last = b[..., -1:, :]
        S_new = (jnp.exp(b_last[..., 0, :])[..., None] * S
                 + jnp.einsum('bhsd,bhsv->bhdv', kb * jnp.exp(b_last - b), vb))
        return S_new, o

    S, o = lax.scan(step, s0, (to_blocks(q), to_blocks(k), to_blocks(v), to_blocks(log_a)))
    o = o.transpose(1, 0, 3, 2, 4).reshape(B, L, H, v.shape[-1])
    return o, S


def spatial_gate(v, w_s, b_s, blk):
    B, L, G, C = v.shape
    n = L // blk
    wm = jnp.where(jnp.tril(jnp.ones((blk, blk), dtype=bool))[None], w_s[:, :blk, :blk], 0.0)
    vb = v.reshape(B, n, blk, G, C)
    s = jnp.einsum('gts,bnsgc->bntgc', wm.astype(v.dtype), vb) + b_s[:, :blk].T[None, None, :, :, None]
    return s.reshape(B, L, G, C)


def layer(x, s0, gla_blk, w_in, w_gate_up, b_gate, w_s, b_s, norm_g, gla_norm_g, mlp_ln_g, mlp_ln_b, w_out):
    B, L, _ = x.shape
    h = rmsnorm(x, norm_g)
    z = jnp.einsum('bld,de->ble', h, w_in)
    q, k, v, g_a, lr, u, vm, g_b = split_projection(z)
    log_a = jax.nn.log_sigmoid((jnp.einsum('blr,rk->blk', lr, w_gate_up) + b_gate).astype(jnp.float32)) / GATE_TEMP
    q = (q * (GLA_DK ** -0.5)).reshape(B, L, GLA_HEADS, GLA_DK)
    k = k.reshape(B, L, GLA_HEADS, GLA_DK)
    v = v.reshape(B, L, GLA_HEADS, GLA_DV)
    log_a = log_a.reshape(B, L, GLA_HEADS, GLA_DK)
    o, S = gla_scan(q, k, v, log_a, s0, gla_blk)
    o_a = rmsnorm(o.astype(x.dtype), gla_norm_g).reshape(B, L, GLA_WIDTH) * jax.nn.silu(g_a)
    vm_n = layernorm(vm.reshape(B, L, MLP_GROUPS, MLP_GC),
                     mlp_ln_g.reshape(MLP_GROUPS, MLP_GC), mlp_ln_b.reshape(MLP_GROUPS, MLP_GC))
    sg = spatial_gate(vm_n, w_s, b_s, min(L, MLP_CHUNK)).reshape(B, L, MLP_WIDTH)
    o_b = u * sg * jax.nn.silu(g_b)
    y = x + jnp.einsum('ble,ed->bld', jnp.concatenate([o_a, o_b], axis=-1), w_out)
    return y, S, vm_n.reshape(B, L, MLP_WIDTH)


def setup_inputs(seed: int = 0) -> dict:
    key = jax.random.key(seed)
    ks = jax.random.split(key, 16)
    f32 = jnp.float32
    return {
        "x_prompt": jax.random.normal(ks[0], (BATCH, SEQ, D_MODEL), f32),
        "x_sample": jax.random.normal(ks[1], (DEC_BATCH, DEC_SEQ, D_MODEL), f32),
        "state_gla": 0.5 * jax.random.normal(ks[2], (DEPTH, DEC_BATCH, GLA_HEADS, GLA_DK, GLA_DV), f32),
        "w_in": jax.random.normal(ks[3], (DEPTH, D_MODEL, D_IN), f32) * D_MODEL ** -0.5,
        "w_gate_up": jax.random.normal(ks[4], (DEPTH, GATE_RANK, GLA_KEY_WIDTH), f32) * GATE_RANK ** -0.5,
        "b_gate": 0.1 * jax.random.normal(ks[5], (DEPTH, GLA_KEY_WIDTH), f32),
        "w_s": jax.random.normal(ks[6], (DEPTH, MLP_GROUPS, MLP_CHUNK, MLP_CHUNK), f32) * MLP_CHUNK ** -0.5,
        "b_s": 1.0 + 0.1 * jax.random.normal(ks[7], (DEPTH, MLP_GROUPS, MLP_CHUNK), f32),
        "norm_g": 1.0 + 0.05 * jax.random.normal(ks[8], (DEPTH, D_MODEL), f32),
        "gla_norm_g": 1.0 + 0.05 * jax.random.normal(ks[9], (DEPTH, GLA_DV), f32),
        "mlp_ln_g": 1.0 + 0.05 * jax.random.normal(ks[10], (DEPTH, MLP_WIDTH), f32),
        "mlp_ln_b": 0.05 * jax.random.normal(ks[11], (DEPTH, MLP_WIDTH), f32),
        "w_out": jax.random.normal(ks[12], (DEPTH, D_MIX, D_MODEL), f32) * D_MIX ** -0.5,
        "final_norm_g": 1.0 + 0.05 * jax.random.normal(ks[13], (D_MODEL,), f32),
    }


def reference(x_prompt, x_sample, state_gla, w_in, w_gate_up, b_gate, w_s, b_s, norm_g, gla_norm_g,
              mlp_ln_g, mlp_ln_b, w_out, final_norm_g):
    yp, ys = x_prompt, x_sample
    gla_p, gla_s, v_s = [], [], []
    for l in range(DEPTH):
        params = (w_in[l], w_gate_up[l], b_gate[l], w_s[l], b_s[l], norm_g[l], gla_norm_g[l],
                  mlp_ln_g[l], mlp_ln_b[l], w_out[l])
        s0_p = jnp.zeros((yp.shape[0], GLA_HEADS, GLA_DK, GLA_DV), jnp.float32)
        yp, Sp, _ = layer(yp, s0_p, CHUNK, *params)
        ys, Ss, vs = layer(ys, state_gla[l].astype(jnp.float32), ys.shape[1], *params)
        gla_p.append(Sp.astype(x_prompt.dtype))
        gla_s.append(Ss.astype(state_gla.dtype))
        v_s.append(vs)
    y_prompt = rmsnorm(yp, final_norm_g)
    y_sample = rmsnorm(ys, final_norm_g)
    gla_state_prompt = jnp.stack(gla_p)
    gla_state_sample = jnp.stack(gla_s)
    mlp_v_sample = jnp.stack(v_s)
    return (y_prompt, y_sample, gla_state_prompt, gla_state_sample, mlp_v_sample)
```

```cpp
#include <hip/hip_runtime.h>
#include <hip/hip_cooperative_groups.h>
#include <cstdio>
#include <cstdint>
namespace cg = cooperative_groups;

#define LAS __attribute__((address_space(3)))
typedef unsigned short u16;
typedef short bf16x8 __attribute__((ext_vector_type(8)));
typedef float f32x4 __attribute__((ext_vector_type(4)));
typedef unsigned u32x4 __attribute__((ext_vector_type(4)));
typedef unsigned u32x2 __attribute__((ext_vector_type(2)));

constexpr int T = 16896, TP = 16384, DM = 2048, DEPTH = 4, DIN = 6160;
constexpr int NZROWS = 6400;
constexpr int NCH = 264;
constexpr int NTHREADS = 512;
#ifndef PROBE_DUP
#define PROBE_DUP 0
#endif
constexpr int LDS_BYTES = 131072 + 256 + 1024;
constexpr float EPS = 1e-6f;
constexpr float SS_SCALE = 1048576.f, SS_INV = 1.f / (1048576.f * 2048.f);
typedef unsigned long long u64;
__device__ __forceinline__ float rstd_of(u64 s) { return rsqrtf((float)s * SS_INV + EPS); }

constexpr size_t AL(size_t x) { return (x + 255) & ~(size_t)255; }
constexpr size_t WS_WTIN = 0;
constexpr size_t WS_WTOUT = WS_WTIN + AL((size_t)DEPTH * NZROWS * 2048 * 2);
constexpr size_t WS_XRES = WS_WTOUT + AL((size_t)DEPTH * 2048 * 2048 * 2);
constexpr size_t WS_XB = WS_XRES + AL((size_t)T * 2048 * 4);
constexpr size_t WS_ZQ = WS_XB + AL((size_t)T * 2048 * 2);
constexpr size_t WS_ZK = WS_ZQ + AL((size_t)T * 512 * 2);
constexpr size_t WS_ZVT = WS_ZK + AL((size_t)T * 512 * 2);
constexpr size_t WS_ZGA = WS_ZVT + AL((size_t)T * 1024 * 2);
constexpr size_t WS_ZU = WS_ZGA + AL((size_t)T * 1024 * 2);
constexpr size_t WS_ZVMT = WS_ZU + AL((size_t)T * 1024 * 2);
constexpr size_t WS_ZGB = WS_ZVMT + AL((size_t)T * 1024 * 2);
constexpr size_t WS_ZLR = WS_ZGB + AL((size_t)T * 1024 * 2);
constexpr size_t WS_UT = WS_ZLR + AL((size_t)T * 16 * 4);
constexpr size_t WS_SP = WS_UT + AL((size_t)NCH * 4 * 32768 * 2);
constexpr size_t WS_DEC = WS_SP + AL((size_t)NCH * 4 * 32768 * 2);
constexpr size_t WS_OBUF = WS_DEC + AL((size_t)NCH * 4 * 128 * 4);
constexpr size_t WS_SUMSQ = WS_OBUF + AL((size_t)T * 2048 * 2);
constexpr size_t WS_BAR = WS_SUMSQ + AL((size_t)5 * T * 8);
constexpr size_t WS_BCUM = WS_BAR + 16384;
constexpr size_t WS_WSB = WS_BCUM + AL((size_t)T * 512 * 4);
constexpr size_t WS_END = WS_WSB + AL((size_t)DEPTH * 4 * 128 * 128 * 2);

constexpr size_t OFF_Y = 0;
constexpr size_t OFF_GSP = (size_t)T * 2048;
constexpr size_t OFF_GSS = OFF_GSP + (size_t)DEPTH * 4 * 32768;
constexpr size_t OFF_MVS = OFF_GSS + (size_t)DEPTH * 8 * 4 * 32768;

struct Params {
    const float *x_prompt, *x_sample, *state_gla, *w_in, *w_gate_up, *b_gate, *w_s, *b_s, *norm_g, *gla_norm_g, *mlp_ln_g, *mlp_ln_b, *w_out, *final_norm_g;
    float* out; unsigned char* ws;
};

__device__ __forceinline__ unsigned cvt_pk_bf16(float lo, float hi) { unsigned r; asm("v_cvt_pk_bf16_f32 %0, %1, %2" : "=v"(r) : "v"(lo), "v"(hi)); return r; }
__device__ __forceinline__ u16 f2bf(float f) { return (u16)(cvt_pk_bf16(f, 0.f) & 0xffffu); }
__device__ __forceinline__ float bf2f(u16 b) { return __uint_as_float(((unsigned)b) << 16); }
__device__ __forceinline__ float bflo(unsigned w) { return __uint_as_float(w << 16); }
__device__ __forceinline__ float bfhi(unsigned w) { return __uint_as_float(w & 0xffff0000u); }
__device__ __forceinline__ float silu(float x) { return x / (1.f + __expf(-x)); }

__device__ __forceinline__ void phase_prep(const Params& p, LAS unsigned char* lds) {
    int tid = threadIdx.x; asm volatile("" : "+v"(tid));
    const int lane = tid & 63, wid = tid >> 6;
    unsigned char* ws = p.ws;
    u64* sumsq = (u64*)(ws + WS_SUMSQ);
    for (int i = blockIdx.x * NTHREADS + tid; i < 4 * T; i += gridDim.x * NTHREADS) sumsq[T + i] = 0ull;
    u16* xb = (u16*)(ws + WS_XB);
    for (int row = blockIdx.x * 8 + wid; row < T; row += gridDim.x * 16) {
        const int row2 = row + gridDim.x * 8; const bool has2 = row2 < T;
        const float* xr = row < TP ? p.x_prompt + (size_t)row * 2048 : p.x_sample + (size_t)(row - TP) * 2048;
        const float* xr2 = has2 ? (row2 < TP ? p.x_prompt + (size_t)row2 * 2048 : p.x_sample + (size_t)(row2 - TP) * 2048) : xr;
        f32x4 va[8], vb[8];
#pragma unroll
        for (int j = 0; j < 8; ++j) { va[j] = *(const f32x4*)(xr + j * 256 + lane * 4); vb[j] = *(const f32x4*)(xr2 + j * 256 + lane * 4); }
        float ss = 0.f, ss2 = 0.f;
#pragma unroll
        for (int j = 0; j < 8; ++j) {
            ss += va[j][0] * va[j][0] + va[j][1] * va[j][1] + va[j][2] * va[j][2] + va[j][3] * va[j][3];
            ss2 += vb[j][0] * vb[j][0] + vb[j][1] * vb[j][1] + vb[j][2] * vb[j][2] + vb[j][3] * vb[j][3];
            u32x2 w; w.x = cvt_pk_bf16(va[j][0], va[j][1]); w.y = cvt_pk_bf16(va[j][2], va[j][3]);
            *(u32x2*)(xb + (size_t)row * 2048 + j * 256 + lane * 4) = w;
            if (has2) { u32x2 w2; w2.x = cvt_pk_bf16(vb[j][0], vb[j][1]); w2.y = cvt_pk_bf16(vb[j][2], vb[j][3]);
                *(u32x2*)(xb + (size_t)row2 * 2048 + j * 256 + lane * 4) = w2; }
        }
#pragma unroll
        for (int o = 32; o >= 1; o >>= 1) { ss += __shfl_xor(ss, o); ss2 += __shfl_xor(ss2, o); }
        if (lane == 0) { sumsq[row] = (u64)(ss * SS_SCALE); if (has2) sumsq[row2] = (u64)(ss2 * SS_SCALE); }
    }
    for (int e = blockIdx.x * NTHREADS + tid; e < DEPTH * 2048 * 16; e += gridDim.x * NTHREADS) {
        const int l = e / (2048 * 16), r = e % (2048 * 16), k = r >> 4, n = r & 15;
        const float v = p.w_in[((size_t)l * 2048 + k) * DIN + 3072 + n] * p.norm_g[l * 2048 + k];
        ((u16*)(ws + WS_WTIN))[((size_t)l * NZROWS + 6144 + n) * 2048 + k] = f2bf(v);
    }
    for (int e = blockIdx.x * NTHREADS + tid; e < DEPTH * 4 * 128 * 128; e += gridDim.x * NTHREADS) {
        const int t = (e >> 7) & 127, s = e & 127;
        ((u16*)(ws + WS_WSB))[e] = f2bf(s <= t ? p.w_s[e] : 0.f);
    }
    LAS float* tile = (LAS float*)lds;
#define PREP_DECODE(job, src, dst, ldsrc, k0, n0, srccol0, g) do { const int _l = (job) >> 10; int _r = (job) & 1023; int _kt, _nb; \
        if (_r < 768) { _kt = _r / 24; _nb = _r % 24; src = p.w_in + (size_t)_l * 2048 * DIN; ldsrc = DIN; srccol0 = _nb * 256 + (_nb >= 12 ? 16 : 0); \
            dst = (u16*)(ws + WS_WTIN) + (size_t)_l * NZROWS * 2048; g = p.norm_g + _l * 2048; } \
        else { _r -= 768; _kt = _r >> 3; _nb = _r & 7; src = p.w_out + (size_t)_l * 2048 * 2048; ldsrc = 2048; srccol0 = _nb * 256; \
            dst = (u16*)(ws + WS_WTOUT) + (size_t)_l * 2048 * 2048; g = nullptr; } \
        k0 = _kt * 64; n0 = _nb * 256; } while (0)
#define PREP_LOAD(job) do { const float* _src; u16* _dst; int _ld, _k0, _n0, _sc; const float* _g; PREP_DECODE(job, _src, _dst, _ld, _k0, _n0, _sc, _g); (void)_dst; (void)_n0; \
        _Pragma("unroll") for (int i = 0; i < 8; ++i) { const int e = tid + i * 512, rr = e >> 6, c4 = (e & 63) * 4; \
            v[i] = *(const f32x4*)(_src + (size_t)(_k0 + rr) * _ld + _sc + c4); gv[i] = _g ? _g[_k0 + rr] : 1.f; } } while (0)
    {
        f32x4 v[8]; float gv[8];
        int job = blockIdx.x;
        if (job < DEPTH * 1024) PREP_LOAD(job);
        for (; job < DEPTH * 1024; job += gridDim.x) {
            const float* src; u16* dst; int ldsrc, k0, n0, srccol0; const float* g;
            PREP_DECODE(job, src, dst, ldsrc, k0, n0, srccol0, g); (void)src; (void)ldsrc; (void)srccol0; (void)g;
#pragma unroll
            for (int i = 0; i < 8; ++i) { const int e = tid + i * 512, rr = e >> 6, c4 = (e & 63) * 4;
#pragma unroll
                for (int j = 0; j < 4; ++j) tile[rr * 257 + c4 + j] = v[i][j] * gv[i]; }
            const int nextjob = job + gridDim.x;
            if (nextjob < DEPTH * 1024) PREP_LOAD(nextjob);
            __syncthreads();
#pragma unroll
            for (int i = 0; i < 4; ++i) { const int e = tid + i * 512, n = e >> 3, ko = (e & 7) * 8;
                u32x4 wv;
                wv.x = cvt_pk_bf16(tile[(ko + 0) * 257 + n], tile[(ko + 1) * 257 + n]); wv.y = cvt_pk_bf16(tile[(ko + 2) * 257 + n], tile[(ko + 3) * 257 + n]);
                wv.z = cvt_pk_bf16(tile[(ko + 4) * 257 + n], tile[(ko + 5) * 257 + n]); wv.w = cvt_pk_bf16(tile[(ko + 6) * 257 + n], tile[(ko + 7) * 257 + n]);
                *(u32x4*)(dst + (size_t)(n0 + n) * 2048 + k0 + ko) = wv; }
            __syncthreads();
        }
    }
#undef PREP_DECODE
#undef PREP_LOAD
}

constexpr int BM = 256, BK = 64, HALF = 128, HTB = HALF * BK * 2, NXCD = 8, WGM = 8;
__device__ __forceinline__ int lds_byte(int r, int c) { const int st = (r >> 4) * 2 + (c >> 5), rr = r & 15, cc = c & 31, ob = rr * 64 + cc * 2; return st * 1024 + (ob ^ (((ob >> 9) & 1) << 5)); }
__device__ __forceinline__ void stage_rc(int b, int& R, int& C) { const int st = b / 1024, sb = b % 1024, swz = sb ^ (((sb >> 9) & 1) << 5); R = (st >> 1) * 16 + swz / 64; C = (st & 1) * 32 + (swz % 64) / 2; }
__device__ __forceinline__ int perm32(int rho) { const int n = rho >> 4, i = rho & 15; return 8 * (i >> 2) + 4 * n + (i & 3); }
struct Unit { int pm, pn; };
__device__ __forceinline__ bool unit_next(int i, int G, int c, int nM, int nN, Unit& u) {
    const int nwg = nM * nN; const long L = (long)i * G + c; if (L >= nwg) return false;
    int wgid = (int)L; { const int q = nwg / NXCD, r = nwg % NXCD, xcd = wgid % NXCD, off = wgid / NXCD; wgid = (xcd < r ? xcd * (q + 1) : r * (q + 1) + (xcd - r) * q) + off; }
    const int nig = WGM * nN, gid = wgid / nig, fm = gid * WGM, gsz = (nM - fm) < WGM ? (nM - fm) : WGM;
    u.pm = fm + ((wgid % nig) % gsz); u.pn = (wgid % nig) / gsz; return true;
}
template <int MODE> __device__ __forceinline__ bool unit_swapped(const Unit& u) { return MODE == 0 && ((u.pn >= 4 && u.pn < 8) || (u.pn >= 16 && u.pn < 20)); }
template <int MODE> __device__ __forceinline__ void unit_ptrs(const char* act, const char* wt, const Unit& u, const char*& a, const char*& b) {
    const size_t tstep = (size_t)256 * 2048 * 2;
    const char* pa = act + (size_t)u.pm * tstep; const char* pb = wt + (size_t)u.pn * tstep;
    const bool sw = unit_swapped<MODE>(u);
    a = sw ? pb : pa; b = sw ? pa : pb;
}

template <int MODE>
__device__ __forceinline__ void gemm_epilogue(const Params& p, int l, const f32x4 (&acc)[2][2][4][2], const Unit& u, int wr, int wc, int fr, int fq, const LAS float* rl, int pm0) {
    unsigned char* ws = p.ws;
    const __amdgpu_buffer_rsrc_t wsr = __builtin_amdgcn_make_buffer_rsrc((void*)ws, (short)0, (int)WS_END, 0x00020000);
#define WT_STORE16(ptr, val) __builtin_amdgcn_raw_buffer_store_b128((val), wsr, (int)((const char*)(ptr) - (const char*)ws), 0, 16)
    if (MODE == 0) {
        const u64* ss = (const u64*)(ws + WS_SUMSQ) + (size_t)l * T;
        if (!unit_swapped<0>(u)) {
            const int pn = u.pn;
            u16* ob; int ld;
            if (pn < 2) { ob = (u16*)(ws + WS_ZQ) + pn * 256; ld = 512; }
            else if (pn < 4) { ob = (u16*)(ws + WS_ZK) + (pn - 2) * 256; ld = 512; }
            else if (pn < 12) { ob = (u16*)(ws + WS_ZGA) + (pn - 8) * 256; ld = 1024; }
            else if (pn < 16) { ob = (u16*)(ws + WS_ZU) + (pn - 12) * 256; ld = 1024; }
            else { ob = (u16*)(ws + WS_ZGB) + (pn - 20) * 256; ld = 1024; }
#pragma unroll
            for (int ai = 0; ai < 2; ++ai)
#pragma unroll
                for (int m = 0; m < 4; ++m) {
                    const int tok = u.pm * 256 + 128 * ai + 64 * wr + 16 * m + fr;
                    const float rs = (u.pm == pm0) ? rl[128 * ai + 64 * wr + 16 * m + fr] : rstd_of(ss[tok]);
#pragma unroll
                    for (int bj = 0; bj < 2; ++bj) {
                        const f32x4 v0 = acc[ai][bj][m][0] * rs, v1 = acc[ai][bj][m][1] * rs;
                        u32x4 w; w.x = cvt_pk_bf16(v0[0], v0[1]); w.y = cvt_pk_bf16(v0[2], v0[3]); w.z = cvt_pk_bf16(v1[0], v1[1]); w.w = cvt_pk_bf16(v1[2], v1[3]);
                        WT_STORE16(ob + (size_t)tok * ld + 128 * bj + 32 * wc + 8 * fq, w);
                    }
                }
        } else {
            u16* ob = (u.pn < 8) ? (u16*)(ws + WS_ZVT) + (size_t)((u.pn - 4) * 256) * T : (u16*)(ws + WS_ZVMT) + (size_t)((u.pn - 16) * 256) * T;
#pragma unroll
            for (int bj = 0; bj < 2; ++bj) {
                const int tok0 = u.pm * 256 + 128 * bj + 32 * wc + 8 * fq;
                f32x4 s0, s1;
#pragma unroll
                for (int e = 0; e < 4; ++e) { s0[e] = (u.pm == pm0) ? rl[128 * bj + 32 * wc + 8 * fq + e] : rstd_of(ss[tok0 + e]); s1[e] = (u.pm == pm0) ? rl[128 * bj + 32 * wc + 8 * fq + 4 + e] : rstd_of(ss[tok0 + 4 + e]); }
#pragma unroll
                for (int ai = 0; ai < 2; ++ai)
#pragma unroll
                    for (int m = 0; m < 4; ++m) {
                        const int zr = 128 * ai + 64 * wr + 16 * m + fr;
                        const f32x4 v0 = acc[ai][bj][m][0] * s0, v1 = acc[ai][bj][m][1] * s1;
                        u32x4 w; w.x = cvt_pk_bf16(v0[0], v0[1]); w.y = cvt_pk_bf16(v0[2], v0[3]); w.z = cvt_pk_bf16(v1[0], v1[1]); w.w = cvt_pk_bf16(v1[2], v1[3]);
                        WT_STORE16(ob + (size_t)zr * T + tok0, w);
                    }
            }
        }
    } else {
        u16* xb = (u16*)(ws + WS_XB);
        u64* ssn = (u64*)(ws + WS_SUMSQ) + (size_t)(l + 1) * T;
#pragma unroll
        for (int ai = 0; ai < 2; ++ai)
#pragma unroll
            for (int m = 0; m < 4; ++m) {
                const int tok = u.pm * 256 + 128 * ai + 64 * wr + 16 * m + fr;
                float part = 0.f;
#pragma unroll
                for (int bj = 0; bj < 2; ++bj) {
                    const size_t idx = (size_t)tok * 2048 + u.pn * 256 + 128 * bj + 32 * wc + 8 * fq;
                    const u32x4 xw = *(const u32x4*)(xb + idx);
                    f32x4 y0 = (f32x4){bflo(xw.x), bfhi(xw.x), bflo(xw.y), bfhi(xw.y)}, y1 = (f32x4){bflo(xw.z), bfhi(xw.z), bflo(xw.w), bfhi(xw.w)};
                    y0 += acc[ai][bj][m][0]; y1 += acc[ai][bj][m][1];
                    part += y0[0] * y0[0] + y0[1] * y0[1] + y0[2] * y0[2] + y0[3] * y0[3] + y1[0] * y1[0] + y1[1] * y1[1] + y1[2] * y1[2] + y1[3] * y1[3];
                    u32x4 w; w.x = cvt_pk_bf16(y0[0], y0[1]); w.y = cvt_pk_bf16(y0[2], y0[3]); w.z = cvt_pk_bf16(y1[0], y1[1]); w.w = cvt_pk_bf16(y1[2], y1[3]);
                    WT_STORE16(xb + idx, w);
                }
                part += __shfl_xor(part, 16); part += __shfl_xor(part, 32);
                if (fq == 0) atomicAdd(ssn + tok, (u64)(part * SS_SCALE));
            }
    }
}

#undef WT_STORE16
template <int MODE>
__device__ __forceinline__ void gemm_phase(LAS unsigned char* lds, const Params& p, int l, int single) {
    int tid = threadIdx.x; asm volatile("" : "+v"(tid)); asm volatile("" : "+s"(l));
    const int wid = __builtin_amdgcn_readfirstlane(tid >> 6), lane = tid & 63, wr = wid >> 2, wc = wid & 3, fr = lane & 15, fq = lane >> 4;
    constexpr int K = 2048, nt = K / BK;
    const int nM = TP / 256, nN = (MODE == 0) ? 24 : 8, G = gridDim.x, cidx = blockIdx.x;
    const char* act = (MODE == 0) ? (const char*)(p.ws + WS_XB) : (const char*)(p.ws + WS_OBUF);
    const char* wt = (MODE == 0) ? (const char*)(p.ws + WS_WTIN) + (size_t)l * NZROWS * 2048 * 2 : (const char*)(p.ws + WS_WTOUT) + (size_t)l * 2048 * 2048 * 2;
    unsigned voffA[2], voffB[2];
#pragma unroll
    for (int i = 0; i < 2; ++i) { int R, C; stage_rc(tid * 16 + i * 8192, R, C); const int Rb = (R & ~31) + perm32(R & 31);
        voffA[i] = (unsigned)(R * K + C) * 2u; voffB[i] = (unsigned)(Rb * K + C) * 2u; }
    const size_t kstep = (size_t)(BK * 2);
    const size_t hstep = (size_t)HALF * K * 2;
    const unsigned ldsw = (unsigned)wid * 1024u;
    const int aoff = lds_byte(wr * 64 + fr, fq * 8), boff = lds_byte(wc * 32 + fr, fq * 8);
#define PG8_SA(b, h) (((b) * 2 + (h)) * HTB)
#define PG8_SB(b, h) ((4 + (b) * 2 + (h)) * HTB)
#define PG8_STAGE(bufoff, gbase, voff) do { _Pragma("unroll") for (int _i = 0; _i < 2; ++_i) \
        __builtin_amdgcn_global_load_lds((const unsigned*)((const char*)(gbase) + (voff)[_i]), (LAS unsigned*)(lds + (bufoff) + ldsw + _i * 8192), 16, 0, 0); } while (0)
#define PG8_LDA(dst, b, h) do { _Pragma("unroll") for (int m = 0; m < 4; ++m) _Pragma("unroll") for (int k = 0; k < 2; ++k) dst[m][k] = *(const LAS bf16x8*)(lds + PG8_SA(b, h) + aoff + m * 2048 + k * 1024); } while (0)
#define PG8_LDB(dst, b, h) do { _Pragma("unroll") for (int n = 0; n < 2; ++n) _Pragma("unroll") for (int k = 0; k < 2; ++k) dst[n][k] = *(const LAS bf16x8*)(lds + PG8_SB(b, h) + boff + n * 2048 + k * 1024); } while (0)
#define PG8_MMA(ai, bj, At, Bt) do { __builtin_amdgcn_s_setprio(1); _Pragma("unroll") for (int m = 0; m < 4; ++m) _Pragma("unroll") for (int n = 0; n < 2; ++n) _Pragma("unroll") for (int k = 0; k < 2; ++k) \
        acc[ai][bj][m][n] = __builtin_amdgcn_mfma_f32_16x16x32_bf16(Bt[n][k], At[m][k], acc[ai][bj][m][n], 0, 0, 0); __builtin_amdgcn_s_setprio(0); } while (0)
#define PG8_WAIT_V(n) asm volatile("s_waitcnt vmcnt(" #n ")" ::: "memory")
#define PG8_WAIT_L(n) asm volatile("s_waitcnt lgkmcnt(" #n ")" ::: "memory")
#define PG8_BAR __builtin_amdgcn_s_barrier()
#define PG8_SCHED __builtin_amdgcn_sched_barrier(0)
    Unit cur, nxt; int ui = 0;
    if (single >= 0) { cur.pm = nM + single / nN; cur.pn = single % nN; }
    else if (!unit_next(0, G, cidx, nM, nN, cur)) return;
    LAS float* rl = (LAS float*)(lds + 131072 + 256);
    const int pm0 = cur.pm;
    if (MODE == 0) {
        if (tid < 256) rl[tid] = rstd_of(((const u64*)(p.ws + WS_SUMSQ))[(size_t)l * T + pm0 * 256 + tid]);
        __syncthreads();
    }
    f32x4 acc[2][2][4][2];
#pragma unroll
    for (int a = 0; a < 2; ++a)
#pragma unroll
        for (int b = 0; b < 2; ++b)
#pragma unroll
            for (int m = 0; m < 4; ++m)
#pragma unroll
                for (int n = 0; n < 2; ++n) acc[a][b][m][n] = (f32x4){0.f, 0.f, 0.f, 0.f};
    bf16x8 At[4][2], B0[2][2], B1[2][2];
    const char *cA, *cB; unit_ptrs<MODE>(act, wt, cur, cA, cB);
    PG8_STAGE(PG8_SB(0, 0), cB, voffB); PG8_STAGE(PG8_SA(0, 0), cA, voffA); PG8_STAGE(PG8_SB(0, 1), cB + hstep, voffB); PG8_STAGE(PG8_SA(0, 1), cA + hstep, voffA);
    if (wr == 1) PG8_BAR;
    PG8_WAIT_V(4); PG8_BAR;
    PG8_STAGE(PG8_SB(1, 0), cB + kstep, voffB); PG8_STAGE(PG8_SA(1, 0), cA + kstep, voffA); PG8_STAGE(PG8_SB(1, 1), cB + hstep + kstep, voffB);
    PG8_WAIT_V(6); PG8_BAR;
    for (;;) {
        const bool has_next = (single < 0) && unit_next(ui + 1, G, cidx, nM, nN, nxt);
        const char *nA = cA, *nB = cB;
        if (has_next) unit_ptrs<MODE>(act, wt, nxt, nA, nB);
        for (int t = 0; t < nt; t += 2) {
            const bool last = (t == nt - 2);
            const char* a1 = cA + (size_t)(t + 1) * kstep;
            const char* a2 = last ? nA : cA + (size_t)(t + 2) * kstep; const char* b2 = last ? nB : cB + (size_t)(t + 2) * kstep;
            const char* a3 = a2 + kstep; const char* b3 = b2 + kstep;
            PG8_LDB(B0, 0, 0); PG8_SCHED; PG8_LDA(At, 0, 0); PG8_STAGE(PG8_SA(1, 1), a1 + hstep, voffA);
            PG8_WAIT_L(8); PG8_BAR; PG8_WAIT_L(0); PG8_MMA(0, 0, At, B0); PG8_BAR; PG8_SCHED;
            PG8_LDB(B1, 0, 1); PG8_STAGE(PG8_SB(0, 0), b2, voffB);
            PG8_BAR; PG8_WAIT_L(0); PG8_MMA(0, 1, At, B1); PG8_BAR;
            PG8_LDA(At, 0, 1); PG8_STAGE(PG8_SA(0, 0), a2, voffA);
            PG8_BAR; PG8_WAIT_L(0); PG8_MMA(1, 0, At, B0); PG8_BAR; PG8_SCHED;
            PG8_STAGE(PG8_SB(0, 1), b2 + hstep, voffB);
            PG8_WAIT_V(6); PG8_BAR; PG8_MMA(1, 1, At, B1); PG8_BAR;
            PG8_LDB(B0, 1, 0); PG8_SCHED; PG8_LDA(At, 1, 0); PG8_STAGE(PG8_SA(0, 1), a2 + hstep, voffA);
            PG8_WAIT_L(8); PG8_BAR; PG8_WAIT_L(0); PG8_MMA(0, 0, At, B0); PG8_BAR; PG8_SCHED;
            PG8_LDB(B1, 1, 1); PG8_STAGE(PG8_SB(1, 0), b3, voffB);
            PG8_BAR; PG8_WAIT_L(0); PG8_MMA(0, 1, At, B1); PG8_BAR;
            PG8_LDA(At, 1, 1); PG8_STAGE(PG8_SA(1, 0), a3, voffA);
            PG8_BAR; PG8_WAIT_L(0); PG8_MMA(1, 0, At, B0); PG8_BAR; PG8_SCHED;
            PG8_STAGE(PG8_SB(1, 1), b3 + hstep, voffB);
            PG8_WAIT_V(6); PG8_BAR; PG8_MMA(1, 1, At, B1); PG8_BAR;
        }
        gemm_epilogue<MODE>(p, l, acc, cur, wr, wc, fr, fq, rl, pm0);
        if (!has_next) break;
#pragma unroll
        for (int a = 0; a < 2; ++a)
#pragma unroll
            for (int b = 0; b < 2; ++b)
#pragma unroll
                for (int m = 0; m < 4; ++m)
#pragma unroll
                    for (int n = 0; n < 2; ++n) acc[a][b][m][n] = (f32x4){0.f, 0.f, 0.f, 0.f};
        cur = nxt; cA = nA; cB = nB; ++ui;
    }
    PG8_WAIT_V(0);
    if (wr == 0) PG8_BAR;
    PG8_BAR;
#undef PG8_SA
#undef PG8_SB
#undef PG8_STAGE
#undef PG8_LDA
#undef PG8_LDB
#undef PG8_MMA
#undef PG8_WAIT_V
#undef PG8_WAIT_L
#undef PG8_BAR
#undef PG8_SCHED
}

__device__ __forceinline__ void gla_gates(const Params& p, int l, int h, int tok0, int d, int tg, LAS float* gsum, float (&b)[16], float& blast) {
    LAS float* lrs = gsum + 25088;
    {
        const int t2 = threadIdx.x;
        if (t2 < 256) *(LAS f32x4*)(lrs + t2 * 4) = *(const f32x4*)((const float*)(p.ws + WS_ZLR) + (size_t)tok0 * 16 + t2 * 4);
    }
    const float* wg = p.w_gate_up + (size_t)l * 16 * 512 + h * 128 + d;
    float w[16];
#pragma unroll
    for (int r = 0; r < 16; ++r) w[r] = wg[r * 512];
    const float bg = p.b_gate[l * 512 + h * 128 + d];
    __syncthreads();
    const LAS float* lr = lrs + (tg * 16) * 16;
    float run = 0.f;
#pragma unroll
    for (int i = 0; i < 16; ++i) {
        float x = bg;
#pragma unroll
        for (int r4 = 0; r4 < 4; ++r4) { const f32x4 a = *(const LAS f32x4*)(lr + i * 16 + r4 * 4);
            x += a[0] * w[r4 * 4] + a[1] * w[r4 * 4 + 1] + a[2] * w[r4 * 4 + 2] + a[3] * w[r4 * 4 + 3]; }
        const float ls = fminf(x, 0.f) - __logf(1.f + __expf(-fabsf(x)));
        run += ls * (1.f / 16.f); b[i] = run;
    }
    gsum[tg * 128 + d] = run;
    __syncthreads();
    float off = 0.f, tot = 0.f;
#pragma unroll
    for (int g = 0; g < 4; ++g) { const float v = gsum[g * 128 + d]; tot += v; if (g < tg) off += v; }
#pragma unroll
    for (int i = 0; i < 16; ++i) b[i] += off;
    blast = tot;
}

__device__ __forceinline__ void gla_local_item(const Params& p, int l, int c, int h, LAS unsigned char* lds) {
    int tid = threadIdx.x; asm volatile("" : "+v"(tid)); asm volatile("" : "+s"(l));
    const int lane = tid & 63, w = tid >> 6, fr = lane & 15, fq = lane >> 4, d = tid & 127, tg = tid >> 7;
    unsigned char* ws = p.ws;
    LAS float* gsum = (LAS float*)lds;
    LAS float* decl = (LAS float*)(lds + 2048);
    LAS unsigned char* kT = lds + 4096;
    const int tok0 = c * 64;
    const u16* kp = (const u16*)(ws + WS_ZK) + (size_t)(tok0 + tg * 16) * 512 + h * 128 + d;
    u16 kraw[16];
#pragma unroll
    for (int i = 0; i < 16; ++i) kraw[i] = kp[i * 512];
    const u16* vt = (const u16*)(ws + WS_ZVT) + (size_t)(h * 256 + w * 32 + fr) * T + tok0 + fq * 8;
    bf16x8 bv[2][2];
#pragma unroll
    for (int kk = 0; kk < 2; ++kk)
#pragma unroll
        for (int n = 0; n < 2; ++n) bv[kk][n] = *(const bf16x8*)(vt + (size_t)(n * 16) * T + kk * 32);
    float b[16], blast;
    gla_gates(p, l, h, tok0, d, tg, gsum, b, blast);
    {
        float* bc = (float*)(ws + WS_BCUM) + (size_t)(tok0 + tg * 16) * 512 + h * 128 + d;
#pragma unroll
        for (int i = 0; i < 16; ++i) bc[i * 512] = b[i];
        unsigned pk[8];
#pragma unroll
        for (int i = 0; i < 8; ++i) {
            const float k0 = bf2f(kraw[2 * i]) * __expf(blast - b[2 * i]);
            const float k1 = bf2f(kraw[2 * i + 1]) * __expf(blast - b[2 * i + 1]);
            pk[i] = cvt_pk_bf16(k0, k1);
        }
        u32x4 w0, w1; w0.x = pk[0]; w0.y = pk[1]; w0.z = pk[2]; w0.w = pk[3]; w1.x = pk[4]; w1.y = pk[5]; w1.z = pk[6]; w1.w = pk[7];
        *(LAS u32x4*)(kT + d * 144 + tg * 32) = w0; *(LAS u32x4*)(kT + d * 144 + tg * 32 + 16) = w1;
        if (tg == 0) { const float dc = __expf(blast); decl[d] = dc; ((float*)(ws + WS_DEC))[(size_t)(c * 4 + h) * 128 + d] = dc; }
    }
    __syncthreads();
    f32x4 acc[8][2];
#pragma unroll
    for (int mt = 0; mt < 8; ++mt) { acc[mt][0] = (f32x4){0.f, 0.f, 0.f, 0.f}; acc[mt][1] = (f32x4){0.f, 0.f, 0.f, 0.f}; }
#pragma unroll
    for (int kk = 0; kk < 2; ++kk) {
#pragma unroll
        for (int mt = 0; mt < 8; ++mt) {
            const bf16x8 a = *(const LAS bf16x8*)(kT + (mt * 16 + fr) * 144 + (kk * 32 + fq * 8) * 2);
#pragma unroll
            for (int n = 0; n < 2; ++n) acc[mt][n] = __builtin_amdgcn_mfma_f32_16x16x32_bf16(a, bv[kk][n], acc[mt][n], 0, 0, 0);
        }
    }
    if (c < 256) {
        u16* ut = (u16*)(ws + WS_UT) + (size_t)(c * 4 + h) * 32768;
#pragma unroll
        for (int mt = 0; mt < 8; ++mt)
#pragma unroll
            for (int n = 0; n < 2; ++n) {
                u32x2 wv; wv.x = cvt_pk_bf16(acc[mt][n][0], acc[mt][n][1]); wv.y = cvt_pk_bf16(acc[mt][n][2], acc[mt][n][3]);
                *(u32x2*)(ut + (w * 32 + n * 16 + fr) * 128 + mt * 16 + fq * 4) = wv;
            }
    } else {
        const int s = c - 256;
        const size_t sidx = (((size_t)l * 8 + s) * 4 + h) * 32768;
        const float* s0 = p.state_gla + sidx;
        float* so = p.out + OFF_GSS + sidx;
        u16* sp = (u16*)(ws + WS_SP) + (size_t)(c * 4 + h) * 32768;
#pragma unroll
        for (int mt = 0; mt < 8; ++mt)
#pragma unroll
            for (int n = 0; n < 2; ++n) {
                const int dv = w * 32 + n * 16 + fr, dk0 = mt * 16 + fq * 4;
                float sv[4];
#pragma unroll
                for (int e = 0; e < 4; ++e) { sv[e] = s0[(dk0 + e) * 256 + dv]; so[(dk0 + e) * 256 + dv] = decl[dk0 + e] * sv[e] + acc[mt][n][e]; }
                u32x2 wv; wv.x = cvt_pk_bf16(sv[0], sv[1]); wv.y = cvt_pk_bf16(sv[2], sv[3]);
                *(u32x2*)(sp + dv * 128 + dk0) = wv;
            }
    }
    __syncthreads();
}

__device__ __forceinline__ void scan_task(const Params& p, int l, int j, LAS unsigned char* lds) {
    unsigned char* ws = p.ws;
    int tid = threadIdx.x; asm volatile("" : "+v"(tid)); asm volatile("" : "+s"(l));
    const int e = j * 2048 + tid * 4;
    const int h = e >> 15, dk = e & 127, dv = (e >> 7) & 255;
    const u16* ut = (const u16*)(ws + WS_UT) + e; u16* sp = (u16*)(ws + WS_SP) + e;
    LAS float* dl = (LAS float*)lds;
    {
        const float* dsrc = (const float*)(ws + WS_DEC) + h * 128;
#pragma unroll
        for (int i = 0; i < 16; ++i) { const int q = tid + i * 512, c = q >> 5, d4 = (q & 31) * 4; *(LAS f32x4*)(dl + c * 128 + d4) = *(const f32x4*)(dsrc + (size_t)c * 512 + d4); }
    }
    f32x4 S = (f32x4){0.f, 0.f, 0.f, 0.f};
    u32x2 uvA[16], uvB[16];
#define SCAN_LOAD(uv, cb) do { _Pragma("unroll") for (int i = 0; i < 16; ++i) uv[i] = *(const u32x2*)(ut + (size_t)((cb) + i) * 131072); } while (0)
#define SCAN_STEP(uv, cb) do { _Pragma("unroll") for (int i = 0; i < 16; ++i) { \
            const f32x4 dd = *(const LAS f32x4*)(dl + ((cb) + i) * 128 + dk); \
            u32x2 wv; wv.x = cvt_pk_bf16(S[0], S[1]); wv.y = cvt_pk_bf16(S[2], S[3]); \
            *(u32x2*)(sp + (size_t)((cb) + i) * 131072) = wv; \
            S[0] = dd[0] * S[0] + bflo(uv[i].x); S[1] = dd[1] * S[1] + bfhi(uv[i].x); \
            S[2] = dd[2] * S[2] + bflo(uv[i].y); S[3] = dd[3] * S[3] + bfhi(uv[i].y); } } while (0)
    SCAN_LOAD(uvA, 0);
    __syncthreads();
    for (int c0 = 0; c0 < 256; c0 += 32) {
        SCAN_LOAD(uvB, c0 + 16);
        SCAN_STEP(uvA, c0);
        if (c0 + 32 < 256) SCAN_LOAD(uvA, c0 + 32);
        SCAN_STEP(uvB, c0 + 16);
    }
#undef SCAN_LOAD
#undef SCAN_STEP
    float* go = p.out + OFF_GSP + ((size_t)l * 4 + h) * 32768 + dk * 256 + dv;
#pragma unroll
    for (int i = 0; i < 4; ++i) go[i * 256] = S[i];
}

template <bool SMP>
__device__ __forceinline__ void gla_out_item(const Params& p, int l, int c, int h, LAS unsigned char* lds, int it_next) {
    int tid = threadIdx.x; asm volatile("" : "+v"(tid)); asm volatile("" : "+s"(l));
    const int lane = tid & 63, w = tid >> 6, fr = lane & 15, fq = lane >> 4, d = tid & 127, tg = tid >> 7;
    unsigned char* ws = p.ws;
    LAS float* red = (LAS float*)(lds + 2048);
    LAS unsigned char* Q = lds + 4096;
    LAS unsigned char* Kt = Q + 17408;
    LAS unsigned char* P = Kt + 17408;
    const int tok0 = c * 64;
    const size_t rowoff = (size_t)(tok0 + tg * 16) * 512 + h * 128 + d;
    const float* bc = (const float*)(ws + WS_BCUM) + rowoff;
    const u16* qp = (const u16*)(ws + WS_ZQ) + rowoff;
    const u16* kp = (const u16*)(ws + WS_ZK) + rowoff;
    float b[16]; u16 qraw[16], kraw[16];
    const int t8 = tid >> 3, dg = (tid & 7) * 16;
    u32x4 qw0, qw1, kw0, kw1; f32x4 bw[4];
    if (!SMP) {
        const size_t ro = (size_t)(tok0 + t8) * 512 + h * 128 + dg;
        qw0 = *(const u32x4*)((const u16*)(ws + WS_ZQ) + ro); qw1 = *(const u32x4*)((const u16*)(ws + WS_ZQ) + ro + 8);
        kw0 = *(const u32x4*)((const u16*)(ws + WS_ZK) + ro); kw1 = *(const u32x4*)((const u16*)(ws + WS_ZK) + ro + 8);
#pragma unroll
        for (int j = 0; j < 4; ++j) bw[j] = *(const f32x4*)((const float*)(ws + WS_BCUM) + ro + 4 * j);
    } else {
#pragma unroll
        for (int i = 0; i < 16; ++i) { qraw[i] = qp[i * 512]; kraw[i] = kp[i * 512]; }
    }
    const u16* vt = (const u16*)(ws + WS_ZVT) + (size_t)(h * 256 + w * 32 + fr) * T + tok0 + fq * 8;
    bf16x8 bv[2][2];
#pragma unroll
    for (int kk = 0; kk < 2; ++kk)
#pragma unroll
        for (int n = 0; n < 2; ++n) bv[kk][n] = *(const bf16x8*)(vt + (size_t)(n * 16) * T + kk * 32);
    const u16* sp = (const u16*)(ws + WS_SP) + (size_t)(c * 4 + h) * 32768 + (size_t)(w * 32 + fr) * 128 + fq * 8;
    bf16x8 bs[4][2];
    if (!SMP) {
#pragma unroll
        for (int kk = 0; kk < 4; ++kk)
#pragma unroll
            for (int n = 0; n < 2; ++n) bs[kk][n] = *(const bf16x8*)(sp + n * 16 * 128 + kk * 32);
    } else {
        const float* s0 = p.state_gla + (((size_t)l * 8 + (c - 256)) * 4 + h) * 32768 + w * 32 + fr;
#pragma unroll
        for (int kk = 0; kk < 4; ++kk)
#pragma unroll
            for (int n = 0; n < 2; ++n) {
                float sv[8];
#pragma unroll
                for (int j = 0; j < 8; ++j) sv[j] = s0[(size_t)(kk * 32 + fq * 8 + j) * 256 + n * 16];
                u32x4 pw; pw.x = cvt_pk_bf16(sv[0], sv[1]); pw.y = cvt_pk_bf16(sv[2], sv[3]); pw.z = cvt_pk_bf16(sv[4], sv[5]); pw.w = cvt_pk_bf16(sv[6], sv[7]);
                bs[kk][n] = __builtin_bit_cast(bf16x8, pw);
            }
    }
    u32x2 gav[4][2];
#pragma unroll
    for (int mt = 0; mt < 4; ++mt)
#pragma unroll
        for (int n = 0; n < 2; ++n) gav[mt][n] = *(const u32x2*)((const u16*)(ws + WS_ZGA) + (size_t)(tok0 + mt * 16 + fr) * 1024 + h * 256 + w * 32 + n * 16 + fq * 4);
    if (!SMP && it_next >= 0) {
        const int wu = __builtin_amdgcn_readfirstlane(w);
        LAS unsigned* dummy = (LAS unsigned*)(lds + 120832 + wu * 1024);
        const int c2 = it_next >> 2, h2 = it_next & 3, tokp = c2 * 64;
#define PF16(ptr) __builtin_amdgcn_global_load_lds((const unsigned*)(ptr), dummy, 16, 0, 0)
#pragma unroll
        for (int i = 0; i < 2; ++i) {
            const size_t ro2 = (size_t)(tokp + wu * 8 + i * 4 + (lane >> 4)) * 512 + h2 * 128 + (lane & 15) * 8;
            PF16((const u16*)(ws + WS_ZQ) + ro2); PF16((const u16*)(ws + WS_ZK) + ro2);
        }
#pragma unroll
        for (int i = 0; i < 4; ++i) {
            const int row = tokp + wu * 8 + i * 2 + (lane >> 5);
            PF16((const float*)(ws + WS_BCUM) + (size_t)row * 512 + h2 * 128 + (lane & 31) * 4);
            PF16((const u16*)(ws + WS_ZGA) + (size_t)row * 1024 + h2 * 256 + (lane & 31) * 8);
        }
#pragma unroll
        for (int i = 0; i < 8; ++i)
            PF16((const u16*)(ws + WS_SP) + (size_t)(c2 * 4 + h2) * 32768 + (size_t)(wu * 8 + i) * 512 + lane * 8);
#pragma unroll
        for (int i = 0; i < 4; ++i)
            PF16((const u16*)(ws + WS_ZVT) + (size_t)(h2 * 256 + wu * 32 + i * 8 + (lane >> 3)) * T + tokp + (lane & 7) * 8);
#undef PF16
    }
    if (SMP) {
        float blast; gla_gates(p, l, h, tok0, d, tg, (LAS float*)lds, b, blast);
#pragma unroll
        for (int i = 0; i < 16; ++i) {
            const int t = tg * 16 + i;
            const float qv = bf2f(qraw[i]) * 0.08838834764831845f * __expf(b[i]);
            const float kv = bf2f(kraw[i]) * __expf(-b[i]);
            ((LAS u16*)Q)[t * 136 + d] = f2bf(qv); ((LAS u16*)Kt)[t * 136 + d] = f2bf(kv);
        }
    } else {
        const unsigned qq[8] = {qw0.x, qw0.y, qw0.z, qw0.w, qw1.x, qw1.y, qw1.z, qw1.w};
        const unsigned kk8[8] = {kw0.x, kw0.y, kw0.z, kw0.w, kw1.x, kw1.y, kw1.z, kw1.w};
        unsigned qo[8], ko[8];
#pragma unroll
        for (int j = 0; j < 8; ++j) {
            const float b0 = bw[j >> 1][(j & 1) * 2], b1 = bw[j >> 1][(j & 1) * 2 + 1];
            const float q0 = bflo(qq[j]) * 0.08838834764831845f * __expf(b0), q1 = bfhi(qq[j]) * 0.08838834764831845f * __expf(b1);
            const float k0 = bflo(kk8[j]) * __expf(-b0), k1 = bfhi(kk8[j]) * __expf(-b1);
            qo[j] = cvt_pk_bf16(q0, q1); ko[j] = cvt_pk_bf16(k0, k1);
        }
        u32x4 w0, w1; w0.x = qo[0]; w0.y = qo[1]; w0.z = qo[2]; w0.w = qo[3]; w1.x = qo[4]; w1.y = qo[5]; w1.z = qo[6]; w1.w = qo[7];
        *(LAS u32x4*)(Q + t8 * 272 + dg * 2) = w0; *(LAS u32x4*)(Q + t8 * 272 + dg * 2 + 16) = w1;
        w0.x = ko[0]; w0.y = ko[1]; w0.z = ko[2]; w0.w = ko[3]; w1.x = ko[4]; w1.y = ko[5]; w1.z = ko[6]; w1.w = ko[7];
        *(LAS u32x4*)(Kt + t8 * 272 + dg * 2) = w0; *(LAS u32x4*)(Kt + t8 * 272 + dg * 2 + 16) = w1;
    }
    __syncthreads();
    {
        const int mt = w >> 1;
#pragma unroll
        for (int j = 0; j < 2; ++j) {
            const int nt = (w & 1) * 2 + j;
            f32x4 s = (f32x4){0.f, 0.f, 0.f, 0.f};
            if (nt <= mt) {
#pragma unroll
                for (int kk = 0; kk < 4; ++kk) {
                    const bf16x8 a = *(const LAS bf16x8*)(Q + (mt * 16 + fr) * 272 + (kk * 32 + fq * 8) * 2);
                    const bf16x8 bq = *(const LAS bf16x8*)(Kt + (nt * 16 + fr) * 272 + (kk * 32 + fq * 8) * 2);
                    s = __builtin_amdgcn_mfma_f32_16x16x32_bf16(a, bq, s, 0, 0, 0);
                }
            }
#pragma unroll
            for (int e = 0; e < 4; ++e) { const int t = mt * 16 + fq * 4 + e, si = nt * 16 + fr; ((LAS u16*)P)[t * 72 + si] = f2bf(si <= t ? s[e] : 0.f); }
        }
    }
    __syncthreads();
    f32x4 o[4][2];
#pragma unroll
    for (int mt = 0; mt < 4; ++mt) { o[mt][0] = (f32x4){0.f, 0.f, 0.f, 0.f}; o[mt][1] = (f32x4){0.f, 0.f, 0.f, 0.f}; }
#pragma unroll
    for (int kk = 0; kk < 2; ++kk) {
#pragma unroll
        for (int mt = 0; mt < 4; ++mt) {
            if (2 * kk <= mt) {
                const bf16x8 a = *(const LAS bf16x8*)(P + (mt * 16 + fr) * 144 + (kk * 32 + fq * 8) * 2);
#pragma unroll
                for (int n = 0; n < 2; ++n) o[mt][n] = __builtin_amdgcn_mfma_f32_16x16x32_bf16(bv[kk][n], a, o[mt][n], 0, 0, 0);
            }
        }
    }
#pragma unroll
    for (int kk = 0; kk < 4; ++kk) {
#pragma unroll
        for (int mt = 0; mt < 4; ++mt) {
            const bf16x8 a = *(const LAS bf16x8*)(Q + (mt * 16 + fr) * 272 + (kk * 32 + fq * 8) * 2);
#pragma unroll
            for (int n = 0; n < 2; ++n) o[mt][n] = __builtin_amdgcn_mfma_f32_16x16x32_bf16(bs[kk][n], a, o[mt][n], 0, 0, 0);
        }
    }
#pragma unroll
    for (int mt = 0; mt < 4; ++mt) {
        float s2 = 0.f;
#pragma unroll
        for (int n = 0; n < 2; ++n)
#pragma unroll
            for (int e = 0; e < 4; ++e) s2 += o[mt][n][e] * o[mt][n][e];
        s2 += __shfl_xor(s2, 16); s2 += __shfl_xor(s2, 32);
        if (fq == 0) red[w * 64 + mt * 16 + fr] = s2;
    }
    __syncthreads();
    const float* gn = p.gla_norm_g + l * 256 + w * 32 + fq * 4;
    const f32x4 g0 = *(const f32x4*)gn, g1 = *(const f32x4*)(gn + 16);
#pragma unroll
    for (int mt = 0; mt < 4; ++mt) {
        const int t = mt * 16 + fr;
        float tot = 0.f;
#pragma unroll
        for (int ww = 0; ww < 8; ++ww) tot += red[ww * 64 + t];
        const float rs = rsqrtf(tot * (1.f / 256.f) + EPS);
#pragma unroll
        for (int n = 0; n < 2; ++n) {
            const f32x4 gg = n ? g1 : g0; const u32x2 ga = gav[mt][n];
            const float o0 = o[mt][n][0] * rs * gg[0] * silu(bflo(ga.x)), o1 = o[mt][n][1] * rs * gg[1] * silu(bfhi(ga.x));
            const float o2 = o[mt][n][2] * rs * gg[2] * silu(bflo(ga.y)), o3 = o[mt][n][3] * rs * gg[3] * silu(bfhi(ga.y));
            u32x2 wv; wv.x = cvt_pk_bf16(o0, o1); wv.y = cvt_pk_bf16(o2, o3);
            *(u32x2*)((u16*)(ws + WS_OBUF) + (size_t)(tok0 + t) * 2048 + h * 256 + w * 32 + n * 16 + fq * 4) = wv;
        }
    }
    __syncthreads();
}

__device__ __forceinline__ void lr_item(const Params& p, int l, int c, LAS unsigned char* lds) {
    int tid = threadIdx.x; asm volatile("" : "+v"(tid)); asm volatile("" : "+s"(l));
    const int lane = tid & 63, w = tid >> 6, fr = lane & 15, fq = lane >> 4;
    unsigned char* ws = p.ws;
    const u16* xb = (const u16*)(ws + WS_XB) + (size_t)(c * 64) * 2048 + w * 256 + fq * 8;
    const u16* wl = (const u16*)(ws + WS_WTIN) + ((size_t)l * NZROWS + 6144 + fr) * 2048 + w * 256 + fq * 8;
    f32x4 acc[4];
#pragma unroll
    for (int mt = 0; mt < 4; ++mt) acc[mt] = (f32x4){0.f, 0.f, 0.f, 0.f};
#pragma unroll
    for (int kk = 0; kk < 8; ++kk) {
        const bf16x8 bw = *(const bf16x8*)(wl + kk * 32);
#pragma unroll
        for (int mt = 0; mt < 4; ++mt) {
            const bf16x8 a = *(const bf16x8*)(xb + (size_t)(mt * 16 + fr) * 2048 + kk * 32);
            acc[mt] = __builtin_amdgcn_mfma_f32_16x16x32_bf16(a, bw, acc[mt], 0, 0, 0);
        }
    }
    LAS float* red = (LAS float*)lds;
#pragma unroll
    for (int mt = 0; mt < 4; ++mt)
#pragma unroll
        for (int e = 0; e < 4; ++e) red[w * 1024 + (mt * 16 + fq * 4 + e) * 16 + fr] = acc[mt][e];
    __syncthreads();
    {
        const int o = tid * 2, t = o >> 4;
        float s0 = 0.f, s1 = 0.f;
#pragma unroll
        for (int ww = 0; ww < 8; ++ww) { s0 += red[ww * 1024 + o]; s1 += red[ww * 1024 + o + 1]; }
        const float rs = rstd_of(((const u64*)(ws + WS_SUMSQ))[(size_t)l * T + c * 64 + t]);
        float* zl = (float*)(ws + WS_ZLR) + (size_t)(c * 64) * 16 + o;
        zl[0] = s0 * rs; zl[1] = s1 * rs;
    }
    __syncthreads();
}

__device__ __forceinline__ void gla_sample_state_item(const Params& p, int l, int sidx4, LAS unsigned char* lds) {
    int tid = threadIdx.x; asm volatile("" : "+v"(tid)); asm volatile("" : "+s"(l));
    const int lane = tid & 63, wv = tid >> 6, fr = lane & 15, fq = lane >> 4, d = tid & 127, tg = tid >> 7;
    const int s = sidx4 >> 2, h = sidx4 & 3, tok0 = TP + s * 64;
    unsigned char* ws = p.ws;
    LAS float* gs = (LAS float*)(lds + 8192);
    LAS float* dl = (LAS float*)(lds + 8192 + 2048);
    LAS unsigned char* kt = lds + 16384;
    const u16* kp = (const u16*)(ws + WS_ZK) + (size_t)(tok0 + tg * 16) * 512 + h * 128 + d;
    u16 kr[16];
#pragma unroll
    for (int i = 0; i < 16; ++i) kr[i] = kp[i * 512];
    float b[16], blast;
    gla_gates(p, l, h, tok0, d, tg, gs, b, blast);
#pragma unroll
    for (int i = 0; i < 16; ++i) ((LAS u16*)kt)[d * 72 + tg * 16 + i] = f2bf(bf2f(kr[i]) * __expf(blast - b[i]));
    if (tg == 0) dl[d] = __expf(blast);
    __syncthreads();
    const u16* vt = (const u16*)(ws + WS_ZVT) + (size_t)(h * 256 + wv * 32 + fr) * T + tok0 + fq * 8;
    const size_t so_off = (((size_t)l * 8 + s) * 4 + h) * 32768;
    const float* s0 = p.state_gla + so_off;
    float* so = p.out + OFF_GSS + so_off;
#pragma unroll
    for (int n = 0; n < 2; ++n) {
        const bf16x8 v0 = *(const bf16x8*)(vt + (size_t)(n * 16) * T), v1 = *(const bf16x8*)(vt + (size_t)(n * 16) * T + 32);
        const int dv = wv * 32 + n * 16 + fr;
#pragma unroll
        for (int mt = 0; mt < 8; ++mt) {
            f32x4 a = (f32x4){0.f, 0.f, 0.f, 0.f};
            const bf16x8 k0 = *(const LAS bf16x8*)(kt + (mt * 16 + fr) * 144 + (fq * 8) * 2), k1 = *(const LAS bf16x8*)(kt + (mt * 16 + fr) * 144 + (32 + fq * 8) * 2);
            a = __builtin_amdgcn_mfma_f32_16x16x32_bf16(k0, v0, a, 0, 0, 0);
            a = __builtin_amdgcn_mfma_f32_16x16x32_bf16(k1, v1, a, 0, 0, 0);
            const int dk0 = mt * 16 + fq * 4;
#pragma unroll
            for (int e = 0; e < 4; ++e) so[(dk0 + e) * 256 + dv] = dl[dk0 + e] * s0[(dk0 + e) * 256 + dv] + a[e];
        }
    }
    __syncthreads();
}

__device__ __forceinline__ void gmlp_item(const Params& p, int l, int mc, int g, LAS unsigned char* lds) {
    int tid = threadIdx.x; asm volatile("" : "+v"(tid)); asm volatile("" : "+s"(l));
    const int lane = tid & 63, w = tid >> 6, fr = lane & 15, fq = lane >> 4;
    unsigned char* ws = p.ws;
    LAS float* rsum = (LAS float*)lds;
    LAS float* rsq = (LAS float*)(lds + 2048);
    LAS unsigned char* Vn = lds + 4096;
    LAS float* lnp = (LAS float*)(lds + 4096 + 69632);
    lnp[tid] = (tid < 256) ? p.mlp_ln_g[l * 1024 + g * 256 + tid] : p.mlp_ln_b[l * 1024 + g * 256 + tid - 256];
    const bool smp = mc >= 128;
    const int ntok = smp ? 64 : 128, tok0 = smp ? TP + (mc - 128) * 64 : mc * 128;
    const int tk = tid & 127, cq = tid >> 7; const bool active = tk < ntok;
    const int oct = tid & 15, row0 = tid >> 4; const bool act8 = oct * 8 < ntok;
    LAS float* part = (LAS float*)(lds + 77824);
    LAS float* stat = (LAS float*)(lds + 77824 + 8192);
    u32x4 raw[8];
    {
        const u16* vp = (const u16*)(ws + WS_ZVMT) + (size_t)(g * 256 + row0) * T + tok0 + oct * 8;
#pragma unroll
        for (int i = 0; i < 8; ++i) raw[i] = act8 ? *(const u32x4*)(vp + (size_t)(32 * i) * T) : (u32x4){0u, 0u, 0u, 0u};
    }
    {
        float ps[8], pq[8];
#pragma unroll
        for (int j = 0; j < 8; ++j) { ps[j] = 0.f; pq[j] = 0.f; }
#pragma unroll
        for (int i = 0; i < 8; ++i) {
            const float x0 = bflo(raw[i].x), x1 = bfhi(raw[i].x), x2 = bflo(raw[i].y), x3 = bfhi(raw[i].y), x4 = bflo(raw[i].z), x5 = bfhi(raw[i].z), x6 = bflo(raw[i].w), x7 = bfhi(raw[i].w);
            ps[0] += x0; pq[0] += x0 * x0; ps[1] += x1; pq[1] += x1 * x1; ps[2] += x2; pq[2] += x2 * x2; ps[3] += x3; pq[3] += x3 * x3;
            ps[4] += x4; pq[4] += x4 * x4; ps[5] += x5; pq[5] += x5 * x5; ps[6] += x6; pq[6] += x6 * x6; ps[7] += x7; pq[7] += x7 * x7;
        }
#pragma unroll
        for (int j = 0; j < 8; ++j) { ps[j] += __shfl_xor(ps[j], 16); ps[j] += __shfl_xor(ps[j], 32); pq[j] += __shfl_xor(pq[j], 16); pq[j] += __shfl_xor(pq[j], 32); }
        if (lane < 16) {
#pragma unroll
            for (int j = 0; j < 8; ++j) { part[(w * 128 + oct * 8 + j) * 2] = ps[j]; part[(w * 128 + oct * 8 + j) * 2 + 1] = pq[j]; }
        }
    }
    __syncthreads();
    if (tid < 128) {
        float S = 0.f, S2 = 0.f;
#pragma unroll
        for (int ww = 0; ww < 8; ++ww) { S += part[(ww * 128 + tid) * 2]; S2 += part[(ww * 128 + tid) * 2 + 1]; }
        const float mu = S * (1.f / 256.f), var = fmaxf(S2 * (1.f / 256.f) - mu * mu, 0.f);
        stat[tid * 2] = mu; stat[tid * 2 + 1] = rsqrtf(var + EPS);
    }
    __syncthreads();
    {
        float mu[8], rs[8];
#pragma unroll
        for (int j = 0; j < 8; ++j) { mu[j] = stat[(oct * 8 + j) * 2]; rs[j] = stat[(oct * 8 + j) * 2 + 1]; }
        float* mvs = p.out + OFF_MVS + (((size_t)l * 8 + (mc - 128)) * 64 + oct * 8) * 1024 + g * 256;
#pragma unroll
        for (int i = 0; i < 8; ++i) {
            const int c = row0 + 32 * i; const float gg = lnp[c], bb = lnp[256 + c];
            float vn[8];
            vn[0] = (bflo(raw[i].x) - mu[0]) * rs[0] * gg + bb; vn[1] = (bfhi(raw[i].x) - mu[1]) * rs[1] * gg + bb;
            vn[2] = (bflo(raw[i].y) - mu[2]) * rs[2] * gg + bb; vn[3] = (bfhi(raw[i].y) - mu[3]) * rs[3] * gg + bb;
            vn[4] = (bflo(raw[i].z) - mu[4]) * rs[4] * gg + bb; vn[5] = (bfhi(raw[i].z) - mu[5]) * rs[5] * gg + bb;
            vn[6] = (bflo(raw[i].w) - mu[6]) * rs[6] * gg + bb; vn[7] = (bfhi(raw[i].w) - mu[7]) * rs[7] * gg + bb;
            u32x4 wv = (u32x4){0u, 0u, 0u, 0u};
            if (act8) {
                wv.x = cvt_pk_bf16(vn[0], vn[1]); wv.y = cvt_pk_bf16(vn[2], vn[3]); wv.z = cvt_pk_bf16(vn[4], vn[5]); wv.w = cvt_pk_bf16(vn[6], vn[7]);
                if (smp) {
#pragma unroll
                    for (int j = 0; j < 8; ++j) mvs[(size_t)j * 1024 + c] = vn[j];
                }
            }
            *(LAS u32x4*)(Vn + c * 272 + oct * 16) = wv;
        }
    }
    __syncthreads();
    const int ntt = ntok >> 4;
    f32x4 acc[2][8];
#pragma unroll
    for (int tt = 0; tt < 8; ++tt) { acc[0][tt] = (f32x4){0.f, 0.f, 0.f, 0.f}; acc[1][tt] = (f32x4){0.f, 0.f, 0.f, 0.f}; }
    const u16* wsb = (const u16*)(ws + WS_WSB) + (size_t)(l * 4 + g) * 128 * 128;
#pragma unroll
    for (int kk = 0; kk < 4; ++kk) {
        bf16x8 a[2];
#pragma unroll
        for (int ct = 0; ct < 2; ++ct) a[ct] = *(const LAS bf16x8*)(Vn + (w * 32 + ct * 16 + fr) * 272 + (kk * 32 + fq * 8) * 2);
#pragma unroll
        for (int tt = 0; tt < 8; ++tt) {
            if ((tt >> 1) >= kk && tt < ntt) {
                const bf16x8 bw = *(const bf16x8*)(wsb + (tt * 16 + fr) * 128 + kk * 32 + fq * 8);
#pragma unroll
                for (int ct = 0; ct < 2; ++ct) acc[ct][tt] = __builtin_amdgcn_mfma_f32_16x16x32_bf16(a[ct], bw, acc[ct][tt], 0, 0, 0);
            }
        }
    }
    const float* bsp = p.b_s + (size_t)(l * 4 + g) * 128;
#pragma unroll
    for (int tt = 0; tt < 8; ++tt) {
        if (tt < ntt) {
            const int tok = tok0 + tt * 16 + fr; const float bs = bsp[tt * 16 + fr];
#pragma unroll
            for (int ct = 0; ct < 2; ++ct) {
                const int cb = g * 256 + w * 32 + ct * 16 + fq * 4;
                const u32x2 uu = *(const u32x2*)((const u16*)(ws + WS_ZU) + (size_t)tok * 1024 + cb);
                const u32x2 gg = *(const u32x2*)((const u16*)(ws + WS_ZGB) + (size_t)tok * 1024 + cb);
                const float o0 = bflo(uu.x) * (acc[ct][tt][0] + bs) * silu(bflo(gg.x));
                const float o1 = bfhi(uu.x) * (acc[ct][tt][1] + bs) * silu(bfhi(gg.x));
                const float o2 = bflo(uu.y) * (acc[ct][tt][2] + bs) * silu(bflo(gg.y));
                const float o3 = bfhi(uu.y) * (acc[ct][tt][3] + bs) * silu(bfhi(gg.y));
                u32x2 wv; wv.x = cvt_pk_bf16(o0, o1); wv.y = cvt_pk_bf16(o2, o3);
                *(u32x2*)((u16*)(ws + WS_OBUF) + (size_t)tok * 2048 + 1024 + cb) = wv;
            }
        }
    }
    __syncthreads();
}

__device__ __forceinline__ void phase_final(const Params& p) {
    int tid = threadIdx.x; asm volatile("" : "+v"(tid));
    const int lane = tid & 63, wid = tid >> 6;
    const u16* xb = (const u16*)(p.ws + WS_XB);
    const u64* ss = (const u64*)(p.ws + WS_SUMSQ) + (size_t)4 * T;
    for (int row = blockIdx.x * 8 + wid; row < T; row += gridDim.x * 8) {
        const float rs = rstd_of(ss[row]);
#pragma unroll
        for (int j = 0; j < 4; ++j) {
            const u32x4 xw = *(const u32x4*)(xb + (size_t)row * 2048 + j * 512 + lane * 8);
            const f32x4 g0 = *(const f32x4*)(p.final_norm_g + j * 512 + lane * 8), g1 = *(const f32x4*)(p.final_norm_g + j * 512 + lane * 8 + 4);
            float* o = p.out + OFF_Y + (size_t)row * 2048 + j * 512 + lane * 8;
            *(f32x4*)o = (f32x4){bflo(xw.x), bfhi(xw.x), bflo(xw.y), bfhi(xw.y)} * rs * g0;
            *(f32x4*)(o + 4) = (f32x4){bflo(xw.z), bfhi(xw.z), bflo(xw.w), bfhi(xw.w)} * rs * g1;
        }
    }
}

#define XB_TMO      128
#define XB_XCNT(j)  (256  + 64 * (j))
#define XB_XSUB(j)  (1280 + 64 * (j))
#define XB_XGEN(j)  (2304 + 64 * (j))
#define XB_TOP      3328
#define XB_TOPGEN   3392
#define XB_QUEUE    3520
#define XB_SPIN_CAP (1u << 20)
__device__ __forceinline__ unsigned xb_ld(unsigned* p)              { return __hip_atomic_load(p, __ATOMIC_RELAXED, __HIP_MEMORY_SCOPE_AGENT); }
__device__ __forceinline__ unsigned xb_add(unsigned* p, unsigned v) { return __hip_atomic_fetch_add(p, v, __ATOMIC_RELAXED, __HIP_MEMORY_SCOPE_AGENT); }
__device__ __forceinline__ unsigned xb_xcc_id() { return (unsigned)__builtin_amdgcn_s_getreg((3 << 11) | 20) & 0xFu; }
#define XB_SPIN(cond, bar) do { unsigned _sp = 0; while (cond) { __builtin_amdgcn_s_sleep(1); \
    if ((++_sp & 255u) == 0u) { if (xb_ld(&(bar)[XB_TMO])) break; if (_sp > XB_SPIN_CAP) { atomicAdd(&(bar)[XB_TMO], 1u); break; } } } } while (0)
struct XcdBarrier { unsigned* bar; unsigned x; volatile LAS unsigned* st; };
__device__ __forceinline__ void xcd_barrier_complete(unsigned* bar, unsigned x, unsigned& nloc, unsigned& nx) {
    const unsigned G = gridDim.x;
    unsigned sum, cnt, mine, sp = 0u;
    for (;;) {
        sum = 0u; cnt = 0u; mine = 0u;
#pragma unroll
        for (unsigned j = 0; j < 16; ++j) { const unsigned c = xb_ld(&bar[XB_XCNT(j)]); sum += c; cnt += (c > 0u) ? 1u : 0u; mine = (j == x) ? c : mine; }
        if (sum == G) break;
        __builtin_amdgcn_s_sleep(1);
        if ((++sp & 255u) == 0u) { if (xb_ld(&bar[XB_TMO])) break; if (sp > XB_SPIN_CAP) { atomicAdd(&bar[XB_TMO], 1u); break; } }
    }
    nloc = mine > 0u ? mine : 1u; nx = cnt > 0u ? cnt : 1u;
}
__device__ __forceinline__ void grid_barrier(const XcdBarrier& b) {
    asm volatile("s_waitcnt vmcnt(0)" ::: "memory");
    __syncthreads();
    if (threadIdx.x == 0) {
        unsigned* bar = b.bar;
        __builtin_amdgcn_s_waitcnt(0);
        unsigned nloc = b.st[0], nx = b.st[1];
        if (nloc == 0u) { xcd_barrier_complete(bar, b.x, nloc, nx); b.st[0] = nloc; b.st[1] = nx; }
        const unsigned old = xb_add(&bar[XB_XSUB(b.x)], 1u);
        const unsigned gen = old / nloc;
        if (old + 1u == (gen + 1u) * nloc) {
            __builtin_amdgcn_fence(__ATOMIC_RELEASE, "agent");
            asm volatile("s_waitcnt vmcnt(0)" ::: "memory");
            const unsigned og = xb_add(&bar[XB_TOP], 1u);
            const unsigned tg = og / nx;
            if (og + 1u == (tg + 1u) * nx) xb_add(&bar[XB_TOPGEN], 1u);
            else XB_SPIN(xb_ld(&bar[XB_TOPGEN]) == tg, bar);
            __builtin_amdgcn_fence(__ATOMIC_ACQUIRE, "agent");
            xb_add(&bar[XB_XGEN(b.x)], 1u);
            asm volatile("s_waitcnt vmcnt(0)" ::: "memory");
        } else {
            XB_SPIN(xb_ld(&bar[XB_XGEN(b.x)]) == gen, bar);
            __builtin_amdgcn_fence(__ATOMIC_ACQUIRE, "agent");
            asm volatile("s_waitcnt vmcnt(0)" ::: "memory");
        }
    }
    __syncthreads();
}

__device__ __forceinline__ int queue_next(unsigned* ctr, LAS int* slot) {
    __syncthreads();
    if (threadIdx.x == 0) *slot = (int)__hip_atomic_fetch_add(ctr, 1u, __ATOMIC_RELAXED, __HIP_MEMORY_SCOPE_AGENT);
    __syncthreads();
    return *slot;
}

__global__ void __launch_bounds__(NTHREADS) fwd_megakernel(Params p) {
    extern __shared__ __attribute__((aligned(16))) unsigned char lds_raw[];
    LAS unsigned char* lds = (LAS unsigned char*)lds_raw;
    cg::grid_group grid = cg::this_grid();
    unsigned* bar = (unsigned*)(p.ws + WS_BAR);
    LAS int* qslot = (LAS int*)(lds + 131072);
    XcdBarrier xb; xb.bar = bar; xb.x = xb_xcc_id(); xb.st = (volatile LAS unsigned*)(lds + 131072 + 16);
    if (threadIdx.x == 0) { xb.st[0] = 0u; xb.st[1] = 0u; (void)xb_add(&bar[XB_XCNT(xb.x)], 1u); }
    __syncthreads();
    grid.sync();
    phase_prep(p, lds);
    if (PROBE_DUP & 1) { grid_barrier(xb); phase_prep(p, lds); }
    grid_barrier(xb);
#pragma unroll 1
    for (int l = 0; l < DEPTH; ++l) {
        const int bx = blockIdx.x;
        {
            const int grp = (bx >> 3) & 1;
#pragma unroll 1
            for (int pass = 0; pass < 2; ++pass) {
                if (pass == grp) for (int c = bx; c < 256; c += gridDim.x) lr_item(p, l, c, lds);
                if (pass == 0) gemm_phase<0>(lds, p, l, -1);
            }
        }
        grid_barrier(xb);
#pragma unroll 1
        for (int sub = 0; sub < 2; ++sub) {
            int start, hi, step;
            if (sub == 0) {
                if (bx < 48) gemm_phase<0>(lds, p, l, bx);
                else if (bx < 56) lr_item(p, l, 256 + bx - 48, lds);
                hi = 832; step = 208; start = (bx < 48) ? hi : bx - 48;
            } else {
                hi = 1024; step = 256; start = (bx >= 48) ? 832 + bx - 48 : hi;
                asm volatile("s_waitcnt vmcnt(0)" ::: "memory");
                __syncthreads();
                if (threadIdx.x == 0) { __builtin_amdgcn_fence(__ATOMIC_ACQUIRE, "agent"); asm volatile("s_waitcnt vmcnt(0)" ::: "memory"); }
                __syncthreads();
            }
            for (int it = start; it < hi; it += step) gla_local_item(p, l, it >> 2, it & 3, lds);
        }
        grid_barrier(xb);
#pragma unroll 1
        for (int sub = 0; sub < 2; ++sub) {
            unsigned* qc = bar + XB_QUEUE + l * 8 + 2;
#pragma unroll 1
            for (int n = 0;; ++n) {
                int code;
                if (sub == 0) {
                    const int q = queue_next(qc, qslot);
                    if (q >= 496) break;
                    code = (q < 400) ? q : (q < 432 ? 64 + 512 + (q - 400) : (q < 464 ? 608 + (q - 432) : 640 + (q - 464)));
                } else {
                    if (bx < 16) { if (n > 0) break; code = 3000 + bx; }
                    else {
                        const int k = bx - 16;
                        if (n < 4) code = 1000 + k + 240 * n;
                        else if (n == 4) code = (k < 64) ? 1000 + k + 960 : 64 + 336 + (k - 64);
                        else break;
                    }
                }
                if (code < 64) scan_task(p, l, code, lds);
                else if (code < 608) gmlp_item(p, l, (code - 64) >> 2, (code - 64) & 3, lds);
                else if (code < 640) gla_out_item<true>(p, l, 256 + ((code - 608) >> 2), (code - 608) & 3, lds, -1);
                else if (code < 672) gla_sample_state_item(p, l, code - 640, lds);
                else if (code < 3000) {
                    const int it = code - 1000, kq = bx - 16;
                    const int itn = (it + 240 < 960) ? it + 240 : ((it < 960 && kq < 64) ? kq + 960 : -1);
                    gla_out_item<false>(p, l, it >> 2, it & 3, lds, itn);
                }
                else gemm_phase<1>(lds, p, l, code - 3000);
            }
            grid_barrier(xb);
        }
        gemm_phase<1>(lds, p, l, -1);
        grid_barrier(xb);
    }
    phase_final(p);
}

extern "C" void kernel_launch(void* const* d_in, const int* in_sizes, int n_in, void* d_out, int out_size, void* d_ws, size_t ws_size, hipStream_t stream) {
    static int grid = 0;
    if (grid == 0) {
        if (n_in != 14 || ws_size < WS_END) { fprintf(stderr, "kernel_launch: unexpected n_in %d / ws_size %zu (need %zu)\n", n_in, ws_size, (size_t)WS_END); grid = -1; return; }
        int dev = 0, cus = 0, per_cu = 0;
        (void)hipGetDevice(&dev);
        (void)hipDeviceGetAttribute(&cus, hipDeviceAttributeMultiprocessorCount, dev);
        if (hipFuncSetAttribute((const void*)fwd_megakernel, hipFuncAttributeMaxDynamicSharedMemorySize, LDS_BYTES) != hipSuccess) { fprintf(stderr, "kernel_launch: hipFuncSetAttribute failed\n"); grid = -1; return; }
        (void)hipOccupancyMaxActiveBlocksPerMultiprocessor(&per_cu, (const void*)fwd_megakernel, NTHREADS, LDS_BYTES);
        (void)hipGetLastError();
        if (per_cu < 1) { fprintf(stderr, "kernel_launch: occupancy query says %d blocks per CU\n", per_cu); per_cu = 1; }
        grid = cus;
    }
    if (grid < 0) return;
    (void)hipMemsetAsync((unsigned char*)d_ws + WS_BAR, 0, 16384, stream);
    Params p{};
    p.x_prompt = (const float*)d_in[0]; p.x_sample = (const float*)d_in[1]; p.state_gla = (const float*)d_in[2]; p.w_in = (const float*)d_in[3];
    p.w_gate_up = (const float*)d_in[4]; p.b_gate = (const float*)d_in[5]; p.w_s = (const float*)d_in[6]; p.b_s = (const float*)d_in[7];
    p.norm_g = (const float*)d_in[8]; p.gla_norm_g = (const float*)d_in[9]; p.mlp_ln_g = (const float*)d_in[10]; p.mlp_ln_b = (const float*)d_in[11];
    p.w_out = (const float*)d_in[12]; p.final_norm_g = (const float*)d_in[13];
    p.out = (float*)d_out; p.ws = (unsigned char*)d_ws;
    void* args[] = {&p};
    hipError_t e = hipLaunchCooperativeKernel((const void*)fwd_megakernel, dim3(grid), dim3(NTHREADS), args, LDS_BYTES, stream);
    if (e != hipSuccess) fprintf(stderr, "cooperative launch failed: %s (grid %d)\n", hipGetErrorString(e), grid);
}
```

```cpp
#include <hip/hip_runtime.h>
#include <hip/hip_cooperative_groups.h>
#include <cstdio>
#include <cstdint>
namespace cg = cooperative_groups;

#define LAS __attribute__((address_space(3)))
typedef unsigned short u16;
typedef short bf16x8 __attribute__((ext_vector_type(8)));
typedef float f32x4 __attribute__((ext_vector_type(4)));
typedef unsigned u32x4 __attribute__((ext_vector_type(4)));
typedef unsigned u32x2 __attribute__((ext_vector_type(2)));

constexpr int T = 16896, TP = 16384, DM = 2048, DEPTH = 4, DIN = 6160;
constexpr int NZROWS = 6400;
constexpr int NCH = 264;
constexpr int NTHREADS = 512;
#ifndef PROBE_DUP
#define PROBE_DUP 0
#endif
constexpr int LDS_BYTES = 131072 + 256 + 1024;
constexpr float EPS = 1e-6f;
constexpr float SS_SCALE = 1048576.f, SS_INV = 1.f / (1048576.f * 2048.f);
typedef unsigned long long u64;
__device__ __forceinline__ float rstd_of(u64 s) { return rsqrtf((float)s * SS_INV + EPS); }

constexpr size_t AL(size_t x) { return (x + 255) & ~(size_t)255; }
constexpr size_t WS_WTIN = 0;
constexpr size_t WS_WTOUT = WS_WTIN + AL((size_t)DEPTH * NZROWS * 2048 * 2);
constexpr size_t WS_XRES = WS_WTOUT + AL((size_t)DEPTH * 2048 * 2048 * 2);
constexpr size_t WS_XB = WS_XRES + AL((size_t)T * 2048 * 4);
constexpr size_t WS_ZQ = WS_XB + AL((size_t)T * 2048 * 2);
constexpr size_t WS_ZK = WS_ZQ + AL((size_t)T * 512 * 2);
constexpr size_t WS_ZVT = WS_ZK + AL((size_t)T * 512 * 2);
constexpr size_t WS_ZGA = WS_ZVT + AL((size_t)T * 1024 * 2);
constexpr size_t WS_ZU = WS_ZGA + AL((size_t)T * 1024 * 2);
constexpr size_t WS_ZVMT = WS_ZU + AL((size_t)T * 1024 * 2);
constexpr size_t WS_ZGB = WS_ZVMT + AL((size_t)T * 1024 * 2);
constexpr size_t WS_ZLR = WS_ZGB + AL((size_t)T * 1024 * 2);
constexpr size_t WS_UT = WS_ZLR + AL((size_t)T * 16 * 4);
constexpr size_t WS_SP = WS_UT + AL((size_t)NCH * 4 * 32768 * 2);
constexpr size_t WS_DEC = WS_SP + AL((size_t)NCH * 4 * 32768 * 2);
constexpr size_t WS_OBUF = WS_DEC + AL((size_t)NCH * 4 * 128 * 4);
constexpr size_t WS_SUMSQ = WS_OBUF + AL((size_t)T * 2048 * 2);
constexpr size_t WS_BAR = WS_SUMSQ + AL((size_t)5 * T * 8);
constexpr size_t WS_BCUM = WS_BAR + 16384;
constexpr size_t WS_WSB = WS_BCUM + AL((size_t)T * 512 * 4);
constexpr size_t WS_END = WS_WSB + AL((size_t)DEPTH * 4 * 128 * 128 * 2);

constexpr size_t OFF_Y = 0;
constexpr size_t OFF_GSP = (size_t)T * 2048;
constexpr size_t OFF_GSS = OFF_GSP + (size_t)DEPTH * 4 * 32768;
constexpr size_t OFF_MVS = OFF_GSS + (size_t)DEPTH * 8 * 4 * 32768;

struct Params {
    const float *x_prompt, *x_sample, *state_gla, *w_in, *w_gate_up, *b_gate, *w_s, *b_s, *norm_g, *gla_norm_g, *mlp_ln_g, *mlp_ln_b, *w_out, *final_norm_g;
    float* out; unsigned char* ws;
};

__device__ __forceinline__ unsigned cvt_pk_bf16(float lo, float hi) { unsigned r; asm("v_cvt_pk_bf16_f32 %0, %1, %2" : "=v"(r) : "v"(lo), "v"(hi)); return r; }
__device__ __forceinline__ u16 f2bf(float f) { return (u16)(cvt_pk_bf16(f, 0.f) & 0xffffu); }
__device__ __forceinline__ float bf2f(u16 b) { return __uint_as_float(((unsigned)b) << 16); }
__device__ __forceinline__ float bflo(unsigned w) { return __uint_as_float(w << 16); }
__device__ __forceinline__ float bfhi(unsigned w) { return __uint_as_float(w & 0xffff0000u); }
__device__ __forceinline__ float silu(float x) { return x / (1.f + __expf(-x)); }

__device__ __forceinline__ void phase_prep(const Params& p, LAS unsigned char* lds) {
    int tid = threadIdx.x; asm volatile("" : "+v"(tid));
    const int lane = tid & 63, wid = tid >> 6;
    unsigned char* ws = p.ws;
    u64* sumsq = (u64*)(ws + WS_SUMSQ);
    for (int i = blockIdx.x * NTHREADS + tid; i < 4 * T; i += gridDim.x * NTHREADS) sumsq[T + i] = 0ull;
    u16* xb = (u16*)(ws + WS_XB);
    for (int row = blockIdx.x * 8 + wid; row < T; row += gridDim.x * 16) {
        const int row2 = row + gridDim.x * 8; const bool has2 = row2 < T;
        const float* xr = row < TP ? p.x_prompt + (size_t)row * 2048 : p.x_sample + (size_t)(row - TP) * 2048;
        const float* xr2 = has2 ? (row2 < TP ? p.x_prompt + (size_t)row2 * 2048 : p.x_sample + (size_t)(row2 - TP) * 2048) : xr;
        f32x4 va[8], vb[8];
#pragma unroll
        for (int j = 0; j < 8; ++j) { va[j] = *(const f32x4*)(xr + j * 256 + lane * 4); vb[j] = *(const f32x4*)(xr2 + j * 256 + lane * 4); }
        float ss = 0.f, ss2 = 0.f;
#pragma unroll
        for (int j = 0; j < 8; ++j) {
            ss += va[j][0] * va[j][0] + va[j][1] * va[j][1] + va[j][2] * va[j][2] + va[j][3] * va[j][3];
            ss2 += vb[j][0] * vb[j][0] + vb[j][1] * vb[j][1] + vb[j][2] * vb[j][2] + vb[j][3] * vb[j][3];
            u32x2 w; w.x = cvt_pk_bf16(va[j][0], va[j][1]); w.y = cvt_pk_bf16(va[j][2], va[j][3]);
            *(u32x2*)(xb + (size_t)row * 2048 + j * 256 + lane * 4) = w;
            if (has2) { u32x2 w2; w2.x = cvt_pk_bf16(vb[j][0], vb[j][1]); w2.y = cvt_pk_bf16(vb[j][2], vb[j][3]);
                *(u32x2*)(xb + (size_t)row2 * 2048 + j * 256 + lane * 4) = w2; }
        }
#pragma unroll
        for (int o = 32; o >= 1; o >>= 1) { ss += __shfl_xor(ss, o); ss2 += __shfl_xor(ss2, o); }
        if (lane == 0) { sumsq[row] = (u64)(ss * SS_SCALE); if (has2) sumsq[row2] = (u64)(ss2 * SS_SCALE); }
    }
    for (int e = blockIdx.x * NTHREADS + tid; e < DEPTH * 2048 * 16; e += gridDim.x * NTHREADS) {
        const int l = e / (2048 * 16), r = e % (2048 * 16), k = r >> 4, n = r & 15;
        const float v = p.w_in[((size_t)l * 2048 + k) * DIN + 3072 + n] * p.norm_g[l * 2048 + k];
        ((u16*)(ws + WS_WTIN))[((size_t)l * NZROWS + 6144 + n) * 2048 + k] = f2bf(v);
    }
    for (int e = blockIdx.x * NTHREADS + tid; e < DEPTH * 4 * 128 * 128; e += gridDim.x * NTHREADS) {
        const int t = (e >> 7) & 127, s = e & 127;
        ((u16*)(ws + WS_WSB))[e] = f2bf(s <= t ? p.w_s[e] : 0.f);
    }
    LAS float* tile = (LAS float*)lds;
#define PREP_DECODE(job, src, dst, ldsrc, k0, n0, srccol0, g) do { const int _l = (job) >> 10; int _r = (job) & 1023; int _kt, _nb; \
        if (_r < 768) { _kt = _r / 24; _nb = _r % 24; src = p.w_in + (size_t)_l * 2048 * DIN; ldsrc = DIN; srccol0 = _nb * 256 + (_nb >= 12 ? 16 : 0); \
            dst = (u16*)(ws + WS_WTIN) + (size_t)_l * NZROWS * 2048; g = p.norm_g + _l * 2048; } \
        else { _r -= 768; _kt = _r >> 3; _nb = _r & 7; src = p.w_out + (size_t)_l * 2048 * 2048; ldsrc = 2048; srccol0 = _nb * 256; \
            dst = (u16*)(ws + WS_WTOUT) + (size_t)_l * 2048 * 2048; g = nullptr; } \
        k0 = _kt * 64; n0 = _nb * 256; } while (0)
#define PREP_LOAD(job) do { const float* _src; u16* _dst; int _ld, _k0, _n0, _sc; const float* _g; PREP_DECODE(job, _src, _dst, _ld, _k0, _n0, _sc, _g); (void)_dst; (void)_n0; \
        _Pragma("unroll") for (int i = 0; i < 8; ++i) { const int e = tid + i * 512, rr = e >> 6, c4 = (e & 63) * 4; \
            v[i] = *(const f32x4*)(_src + (size_t)(_k0 + rr) * _ld + _sc + c4); gv[i] = _g ? _g[_k0 + rr] : 1.f; } } while (0)
    {
        f32x4 v[8]; float gv[8];
        int job = blockIdx.x;
        if (job < DEPTH * 1024) PREP_LOAD(job);
        for (; job < DEPTH * 1024; job += gridDim.x) {
            const float* src; u16* dst; int ldsrc, k0, n0, srccol0; const float* g;
            PREP_DECODE(job, src, dst, ldsrc, k0, n0, srccol0, g); (void)src; (void)ldsrc; (void)srccol0; (void)g;
#pragma unroll
            for (int i = 0; i < 8; ++i) { const int e = tid + i * 512, rr = e >> 6, c4 = (e & 63) * 4;
#pragma unroll
                for (int j = 0; j < 4; ++j) tile[rr * 257 + c4 + j] = v[i][j] * gv[i]; }
            const int nextjob = job + gridDim.x;
            if (nextjob < DEPTH * 1024) PREP_LOAD(nextjob);
            __syncthreads();
#pragma unroll
            for (int i = 0; i < 4; ++i) { const int e = tid + i * 512, n = e >> 3, ko = (e & 7) * 8;
                u32x4 wv;
                wv.x = cvt_pk_bf16(tile[(ko + 0) * 257 + n], tile[(ko + 1) * 257 + n]); wv.y = cvt_pk_bf16(tile[(ko + 2) * 257 + n], tile[(ko + 3) * 257 + n]);
                wv.z = cvt_pk_bf16(tile[(ko + 4) * 257 + n], tile[(ko + 5) * 257 + n]); wv.w = cvt_pk_bf16(tile[(ko + 6) * 257 + n], tile[(ko + 7) * 257 + n]);
                *(u32x4*)(dst + (size_t)(n0 + n) * 2048 + k0 + ko) = wv; }
            __syncthreads();
        }
    }
#undef PREP_DECODE
#undef PREP_LOAD
}

constexpr int BM = 256, BK = 64, HALF = 128, HTB = HALF * BK * 2, NXCD = 8, WGM = 8;
__device__ __forceinline__ int lds_byte(int r, int c) { const int st = (r >> 4) * 2 + (c >> 5), rr = r & 15, cc = c & 31, ob = rr * 64 + cc * 2; return st * 1024 + (ob ^ (((ob >> 9) & 1) << 5)); }
__device__ __forceinline__ void stage_rc(int b, int& R, int& C) { const int st = b / 1024, sb = b % 1024, swz = sb ^ (((sb >> 9) & 1) << 5); R = (st >> 1) * 16 + swz / 64; C = (st & 1) * 32 + (swz % 64) / 2; }
__device__ __forceinline__ int perm32(int rho) { const int n = rho >> 4, i = rho & 15; return 8 * (i >> 2) + 4 * n + (i & 3); }
struct Unit { int pm, pn; };
__device__ __forceinline__ bool unit_next(int i, int G, int c, int nM, int nN, Unit& u) {
    const int nwg = nM * nN; const long L = (long)i * G + c; if (L >= nwg) return false;
    int wgid = (int)L; { const int q = nwg / NXCD, r = nwg % NXCD, xcd = wgid % NXCD, off = wgid / NXCD; wgid = (xcd < r ? xcd * (q + 1) : r * (q + 1) + (xcd - r) * q) + off; }
    const int nig = WGM * nN, gid = wgid / nig, fm = gid * WGM, gsz = (nM - fm) < WGM ? (nM - fm) : WGM;
    u.pm = fm + ((wgid % nig) % gsz); u.pn = (wgid % nig) / gsz; return true;
}
template <int MODE> __device__ __forceinline__ bool unit_swapped(const Unit& u) { return MODE == 0 && ((u.pn >= 4 && u.pn < 8) || (u.pn >= 16 && u.pn < 20)); }
template <int MODE> __device__ __forceinline__ void unit_ptrs(const char* act, const char* wt, const Unit& u, const char*& a, const char*& b) {
    const size_t tstep = (size_t)256 * 2048 * 2;
    const char* pa = act + (size_t)u.pm * tstep; const char* pb = wt + (size_t)u.pn * tstep;
    const bool sw = unit_swapped<MODE>(u);
    a = sw ? pb : pa; b = sw ? pa : pb;
}

template <int MODE>
__device__ __forceinline__ void gemm_epilogue(const Params& p, int l, const f32x4 (&acc)[2][2][4][2], const Unit& u, int wr, int wc, int fr, int fq, const LAS float* rl, int pm0) {
    unsigned char* ws = p.ws;
    const __amdgpu_buffer_rsrc_t wsr = __builtin_amdgcn_make_buffer_rsrc((void*)ws, (short)0, (int)WS_END, 0x00020000);
#define WT_STORE16(ptr, val) __builtin_amdgcn_raw_buffer_store_b128((val), wsr, (int)((const char*)(ptr) - (const char*)ws), 0, 16)
    if (MODE == 0) {
        const u64* ss = (const u64*)(ws + WS_SUMSQ) + (size_t)l * T;
        if (!unit_swapped<0>(u)) {
            const int pn = u.pn;
            u16* ob; int ld;
            if (pn < 2) { ob = (u16*)(ws + WS_ZQ) + pn * 256; ld = 512; }
            else if (pn < 4) { ob = (u16*)(ws + WS_ZK) + (pn - 2) * 256; ld = 512; }
            else if (pn < 12) { ob = (u16*)(ws + WS_ZGA) + (pn - 8) * 256; ld = 1024; }
            else if (pn < 16) { ob = (u16*)(ws + WS_ZU) + (pn - 12) * 256; ld = 1024; }
            else { ob = (u16*)(ws + WS_ZGB) + (pn - 20) * 256; ld = 1024; }
#pragma unroll
            for (int ai = 0; ai < 2; ++ai)
#pragma unroll
                for (int m = 0; m < 4; ++m) {
                    const int tok = u.pm * 256 + 128 * ai + 64 * wr + 16 * m + fr;
                    const float rs = (u.pm == pm0) ? rl[128 * ai + 64 * wr + 16 * m + fr] : rstd_of(ss[tok]);
#pragma unroll
                    for (int bj = 0; bj < 2; ++bj) {
                        const f32x4 v0 = acc[ai][bj][m][0] * rs, v1 = acc[ai][bj][m][1] * rs;
                        u32x4 w; w.x = cvt_pk_bf16(v0[0], v0[1]); w.y = cvt_pk_bf16(v0[2], v0[3]); w.z = cvt_pk_bf16(v1[0], v1[1]); w.w = cvt_pk_bf16(v1[2], v1[3]);
                        WT_STORE16(ob + (size_t)tok * ld + 128 * bj + 32 * wc + 8 * fq, w);
                    }
                }
        } else {
            u16* ob = (u.pn < 8) ? (u16*)(ws + WS_ZVT) + (size_t)((u.pn - 4) * 256) * T : (u16*)(ws + WS_ZVMT) + (size_t)((u.pn - 16) * 256) * T;
#pragma unroll
            for (int bj = 0; bj < 2; ++bj) {
                const int tok0 = u.pm * 256 + 128 * bj + 32 * wc + 8 * fq;
                f32x4 s0, s1;
#pragma unroll
                for (int e = 0; e < 4; ++e) { s0[e] = (u.pm == pm0) ? rl[128 * bj + 32 * wc + 8 * fq + e] : rstd_of(ss[tok0 + e]); s1[e] = (u.pm == pm0) ? rl[128 * bj + 32 * wc + 8 * fq + 4 + e] : rstd_of(ss[tok0 + 4 + e]); }
#pragma unroll
                for (int ai = 0; ai < 2; ++ai)
#pragma unroll
                    for (int m = 0; m < 4; ++m) {
                        const int zr = 128 * ai + 64 * wr + 16 * m + fr;
                        const f32x4 v0 = acc[ai][bj][m][0] * s0, v1 = acc[ai][bj][m][1] * s1;
                        u32x4 w; w.x = cvt_pk_bf16(v0[0], v0[1]); w.y = cvt_pk_bf16(v0[2], v0[3]); w.z = cvt_pk_bf16(v1[0], v1[1]); w.w = cvt_pk_bf16(v1[2], v1[3]);
                        WT_STORE16(ob + (size_t)zr * T + tok0, w);
                    }
            }
        }
    } else {
        u16* xb = (u16*)(ws + WS_XB);
        u64* ssn = (u64*)(ws + WS_SUMSQ) + (size_t)(l + 1) * T;
#pragma unroll
        for (int ai = 0; ai < 2; ++ai)
#pragma unroll
            for (int m = 0; m < 4; ++m) {
                const int tok = u.pm * 256 + 128 * ai + 64 * wr + 16 * m + fr;
                float part = 0.f;
#pragma unroll
                for (int bj = 0; bj < 2; ++bj) {
                    const size_t idx = (size_t)tok * 2048 + u.pn * 256 + 128 * bj + 32 * wc + 8 * fq;
                    const u32x4 xw = *(const u32x4*)(xb + idx);
                    f32x4 y0 = (f32x4){bflo(xw.x), bfhi(xw.x), bflo(xw.y), bfhi(xw.y)}, y1 = (f32x4){bflo(xw.z), bfhi(xw.z), bflo(xw.w), bfhi(xw.w)};
                    y0 += acc[ai][bj][m][0]; y1 += acc[ai][bj][m][1];
                    part += y0[0] * y0[0] + y0[1] * y0[1] + y0[2] * y0[2] + y0[3] * y0[3] + y1[0] * y1[0] + y1[1] * y1[1] + y1[2] * y1[2] + y1[3] * y1[3];
                    u32x4 w; w.x = cvt_pk_bf16(y0[0], y0[1]); w.y = cvt_pk_bf16(y0[2], y0[3]); w.z = cvt_pk_bf16(y1[0], y1[1]); w.w = cvt_pk_bf16(y1[2], y1[3]);
                    WT_STORE16(xb + idx, w);
                }
                part += __shfl_xor(part, 16); part += __shfl_xor(part, 32);
                if (fq == 0) atomicAdd(ssn + tok, (u64)(part * SS_SCALE));
            }
    }
}

#undef WT_STORE16
template <int MODE>
__device__ __forceinline__ void gemm_phase(LAS unsigned char* lds, const Params& p, int l, int single) {
    int tid = threadIdx.x; asm volatile("" : "+v"(tid)); asm volatile("" : "+s"(l));
    const int wid = __builtin_amdgcn_readfirstlane(tid >> 6), lane = tid & 63, wr = wid >> 2, wc = wid & 3, fr = lane & 15, fq = lane >> 4;
    constexpr int K = 2048, nt = K / BK;
    const int nM = TP / 256, nN = (MODE == 0) ? 24 : 8, G = gridDim.x, cidx = blockIdx.x;
    const char* act = (MODE == 0) ? (const char*)(p.ws + WS_XB) : (const char*)(p.ws + WS_OBUF);
    const char* wt = (MODE == 0) ? (const char*)(p.ws + WS_WTIN) + (size_t)l * NZROWS * 2048 * 2 : (const char*)(p.ws + WS_WTOUT) + (size_t)l * 2048 * 2048 * 2;
    unsigned voffA[2], voffB[2];
#pragma unroll
    for (int i = 0; i < 2; ++i) { int R, C; stage_rc(tid * 16 + i * 8192, R, C); const int Rb = (R & ~31) + perm32(R & 31);
        voffA[i] = (unsigned)(R * K + C) * 2u; voffB[i] = (unsigned)(Rb * K + C) * 2u; }
    const size_t kstep = (size_t)(BK * 2);
    const size_t hstep = (size_t)HALF * K * 2;
    const unsigned ldsw = (unsigned)wid * 1024u;
    const int aoff = lds_byte(wr * 64 + fr, fq * 8), boff = lds_byte(wc * 32 + fr, fq * 8);
#define PG8_SA(b, h) (((b) * 2 + (h)) * HTB)
#define PG8_SB(b, h) ((4 + (b) * 2 + (h)) * HTB)
#define PG8_STAGE(bufoff, gbase, voff) do { _Pragma("unroll") for (int _i = 0; _i < 2; ++_i) \
        __builtin_amdgcn_global_load_lds((const unsigned*)((const char*)(gbase) + (voff)[_i]), (LAS unsigned*)(lds + (bufoff) + ldsw + _i * 8192), 16, 0, 0); } while (0)
#define PG8_LDA(dst, b, h) do { _Pragma("unroll") for (int m = 0; m < 4; ++m) _Pragma("unroll") for (int k = 0; k < 2; ++k) dst[m][k] = *(const LAS bf16x8*)(lds + PG8_SA(b, h) + aoff + m * 2048 + k * 1024); } while (0)
#define PG8_LDB(dst, b, h) do { _Pragma("unroll") for (int n = 0; n < 2; ++n) _Pragma("unroll") for (int k = 0; k < 2; ++k) dst[n][k] = *(const LAS bf16x8*)(lds + PG8_SB(b, h) + boff + n * 2048 + k * 1024); } while (0)
#define PG8_MMA(ai, bj, At, Bt) do { __builtin_amdgcn_s_setprio(1); _Pragma("unroll") for (int m = 0; m < 4; ++m) _Pragma("unroll") for (int n = 0; n < 2; ++n) _Pragma("unroll") for (int k = 0; k < 2; ++k) \
        acc[ai][bj][m][n] = __builtin_amdgcn_mfma_f32_16x16x32_bf16(Bt[n][k], At[m][k], acc[ai][bj][m][n], 0, 0, 0); __builtin_amdgcn_s_setprio(0); } while (0)
#define PG8_WAIT_V(n) asm volatile("s_waitcnt vmcnt(" #n ")" ::: "memory")
#define PG8_WAIT_L(n) asm volatile("s_waitcnt lgkmcnt(" #n ")" ::: "memory")
#define PG8_BAR __builtin_amdgcn_s_barrier()
#define PG8_SCHED __builtin_amdgcn_sched_barrier(0)
    Unit cur, nxt; int ui = 0;
    if (single >= 0) { cur.pm = nM + single / nN; cur.pn = single % nN; }
    else if (!unit_next(0, G, cidx, nM, nN, cur)) return;
    LAS float* rl = (LAS float*)(lds + 131072 + 256);
    const int pm0 = cur.pm;
    if (MODE == 0) {
        if (tid < 256) rl[tid] = rstd_of(((const u64*)(p.ws + WS_SUMSQ))[(size_t)l * T + pm0 * 256 + tid]);
        __syncthreads();
    }
    f32x4 acc[2][2][4][2];
#pragma unroll
    for (int a = 0; a < 2; ++a)
#pragma unroll
        for (int b = 0; b < 2; ++b)
#pragma unroll
            for (int m = 0; m < 4; ++m)
#pragma unroll
                for (int n = 0; n < 2; ++n) acc[a][b][m][n] = (f32x4){0.f, 0.f, 0.f, 0.f};
    bf16x8 At[4][2], B0[2][2], B1[2][2];
    const char *cA, *cB; unit_ptrs<MODE>(act, wt, cur, cA, cB);
    PG8_STAGE(PG8_SB(0, 0), cB, voffB); PG8_STAGE(PG8_SA(0, 0), cA, voffA); PG8_STAGE(PG8_SB(0, 1), cB + hstep, voffB); PG8_STAGE(PG8_SA(0, 1), cA + hstep, voffA);
    if (wr == 1) PG8_BAR;
    PG8_WAIT_V(4); PG8_BAR;
    PG8_STAGE(PG8_SB(1, 0), cB + kstep, voffB); PG8_STAGE(PG8_SA(1, 0), cA + kstep, voffA); PG8_STAGE(PG8_SB(1, 1), cB + hstep + kstep, voffB);
    PG8_WAIT_V(6); PG8_BAR;
    for (;;) {
        const bool has_next = (single < 0) && unit_next(ui + 1, G, cidx, nM, nN, nxt);
        const char *nA = cA, *nB = cB;
        if (has_next) unit_ptrs<MODE>(act, wt, nxt, nA, nB);
        for (int t = 0; t < nt; t += 2) {
            const bool last = (t == nt - 2);
            const char* a1 = cA + (size_t)(t + 1) * kstep;
            const char* a2 = last ? nA : cA + (size_t)(t + 2) * kstep; const char* b2 = last ? nB : cB + (size_t)(t + 2) * kstep;
            const char* a3 = a2 + kstep; const char* b3 = b2 + kstep;
            PG8_LDB(B0, 0, 0); PG8_SCHED; PG8_LDA(At, 0, 0); PG8_STAGE(PG8_SA(1, 1), a1 + hstep, voffA);
            PG8_WAIT_L(8); PG8_BAR; PG8_WAIT_L(0); PG8_MMA(0, 0, At, B0); PG8_BAR; PG8_SCHED;
            PG8_LDB(B1, 0, 1); PG8_STAGE(PG8_SB(0, 0), b2, voffB);
            PG8_BAR; PG8_WAIT_L(0); PG8_MMA(0, 1, At, B1); PG8_BAR;
            PG8_LDA(At, 0, 1); PG8_STAGE(PG8_SA(0, 0), a2, voffA);
            PG8_BAR; PG8_WAIT_L(0); PG8_MMA(1, 0, At, B0); PG8_BAR; PG8_SCHED;
            PG8_STAGE(PG8_SB(0, 1), b2 + hstep, voffB);
            PG8_WAIT_V(6); PG8_BAR; PG8_MMA(1, 1, At, B1); PG8_BAR;
            PG8_LDB(B0, 1, 0); PG8_SCHED; PG8_LDA(At, 1, 0); PG8_STAGE(PG8_SA(0, 1), a2 + hstep, voffA);
            PG8_WAIT_L(8); PG8_BAR; PG8_WAIT_L(0); PG8_MMA(0, 0, At, B0); PG8_BAR; PG8_SCHED;
            PG8_LDB(B1, 1, 1); PG8_STAGE(PG8_SB(1, 0), b3, voffB);
            PG8_BAR; PG8_WAIT_L(0); PG8_MMA(0, 1, At, B1); PG8_BAR;
            PG8_LDA(At, 1, 1); PG8_STAGE(PG8_SA(1, 0), a3, voffA);
            PG8_BAR; PG8_WAIT_L(0); PG8_MMA(1, 0, At, B0); PG8_BAR; PG8_SCHED;
            PG8_STAGE(PG8_SB(1, 1), b3 + hstep, voffB);
            PG8_WAIT_V(6); PG8_BAR; PG8_MMA(1, 1, At, B1); PG8_BAR;
        }
        gemm_epilogue<MODE>(p, l, acc, cur, wr, wc, fr, fq, rl, pm0);
        if (!has_next) break;
#pragma unroll
        for (int a = 0; a < 2; ++a)
#pragma unroll
            for (int b = 0; b < 2; ++b)
#pragma unroll
                for (int m = 0; m < 4; ++m)
#pragma unroll
                    for (int n = 0; n < 2; ++n) acc[a][b][m][n] = (f32x4){0.f, 0.f, 0.f, 0.f};
        cur = nxt; cA = nA; cB = nB; ++ui;
    }
    PG8_WAIT_V(0);
    if (wr == 0) PG8_BAR;
    PG8_BAR;
#undef PG8_SA
#undef PG8_SB
#undef PG8_STAGE
#undef PG8_LDA
#undef PG8_LDB
#undef PG8_MMA
#undef PG8_WAIT_V
#undef PG8_WAIT_L
#undef PG8_BAR
#undef PG8_SCHED
}

__device__ __forceinline__ void gla_gates(const Params& p, int l, int h, int tok0, int d, int tg, LAS float* gsum, float (&b)[16], float& blast) {
    LAS float* lrs = gsum + 25088;
    {
        const int t2 = threadIdx.x;
        if (t2 < 256) *(LAS f32x4*)(lrs + t2 * 4) = *(const f32x4*)((const float*)(p.ws + WS_ZLR) + (size_t)tok0 * 16 + t2 * 4);
    }
    const float* wg = p.w_gate_up + (size_t)l * 16 * 512 + h * 128 + d;
    float w[16];
#pragma unroll
    for (int r = 0; r < 16; ++r) w[r] = wg[r * 512];
    const float bg = p.b_gate[l * 512 + h * 128 + d];
    __syncthreads();
    const LAS float* lr = lrs + (tg * 16) * 16;
    float run = 0.f;
#pragma unroll
    for (int i = 0; i < 16; ++i) {
        float x = bg;
#pragma unroll
        for (int r4 = 0; r4 < 4; ++r4) { const f32x4 a = *(const LAS f32x4*)(lr + i * 16 + r4 * 4);
            x += a[0] * w[r4 * 4] + a[1] * w[r4 * 4 + 1] + a[2] * w[r4 * 4 + 2] + a[3] * w[r4 * 4 + 3]; }
        const float ls = fminf(x, 0.f) - __logf(1.f + __expf(-fabsf(x)));
        run += ls * (1.f / 16.f); b[i] = run;
    }
    gsum[tg * 128 + d] = run;
    __syncthreads();
    float off = 0.f, tot = 0.f;
#pragma unroll
    for (int g = 0; g < 4; ++g) { const float v = gsum[g * 128 + d]; tot += v; if (g < tg) off += v; }
#pragma unroll
    for (int i = 0; i < 16; ++i) b[i] += off;
    blast = tot;
}

__device__ __forceinline__ void gla_local_item(const Params& p, int l, int c, int h, LAS unsigned char* lds) {
    int tid = threadIdx.x; asm volatile("" : "+v"(tid)); asm volatile("" : "+s"(l));
    const int lane = tid & 63, w = tid >> 6, fr = lane & 15, fq = lane >> 4, d = tid & 127, tg = tid >> 7;
    unsigned char* ws = p.ws;
    LAS float* gsum = (LAS float*)lds;
    LAS float* decl = (LAS float*)(lds + 2048);
    LAS unsigned char* kT = lds + 4096;
    const int tok0 = c * 64;
    const u16* kp = (const u16*)(ws + WS_ZK) + (size_t)(tok0 + tg * 16) * 512 + h * 128 + d;
    u16 kraw[16];
#pragma unroll
    for (int i = 0; i < 16; ++i) kraw[i] = kp[i * 512];
    const u16* vt = (const u16*)(ws + WS_ZVT) + (size_t)(h * 256 + w * 32 + fr) * T + tok0 + fq * 8;
    bf16x8 bv[2][2];
#pragma unroll
    for (int kk = 0; kk < 2; ++kk)
#pragma unroll
        for (int n = 0; n < 2; ++n) bv[kk][n] = *(const bf16x8*)(vt + (size_t)(n * 16) * T + kk * 32);
    float b[16], blast;
    gla_gates(p, l, h, tok0, d, tg, gsum, b, blast);
    {
        unsigned* bc = (unsigned*)((u16*)(ws + WS_BCUM) + (size_t)(tok0 + tg * 16) * 512 + h * 128 + (d & ~1));
#pragma unroll
        for (int i = 0; i < 16; ++i) {
            const float ev = __expf(b[i]);
            const float eo = __shfl_down(ev, 1);
            if ((d & 1) == 0) bc[i * 256] = cvt_pk_bf16(ev, eo);
        }
        unsigned pk[8];
#pragma unroll
        for (int i = 0; i < 8; ++i) {
            const float k0 = bf2f(kraw[2 * i]) * __expf(blast - b[2 * i]);
            const float k1 = bf2f(kraw[2 * i + 1]) * __expf(blast - b[2 * i + 1]);
            pk[i] = cvt_pk_bf16(k0, k1);
        }
        u32x4 w0, w1; w0.x = pk[0]; w0.y = pk[1]; w0.z = pk[2]; w0.w = pk[3]; w1.x = pk[4]; w1.y = pk[5]; w1.z = pk[6]; w1.w = pk[7];
        *(LAS u32x4*)(kT + d * 144 + tg * 32) = w0; *(LAS u32x4*)(kT + d * 144 + tg * 32 + 16) = w1;
        if (tg == 0) { const float dc = __expf(blast); decl[d] = dc; ((float*)(ws + WS_DEC))[(size_t)(c * 4 + h) * 128 + d] = dc; }
    }
    __syncthreads();
    f32x4 acc[8][2];
#pragma unroll
    for (int mt = 0; mt < 8; ++mt) { acc[mt][0] = (f32x4){0.f, 0.f, 0.f, 0.f}; acc[mt][1] = (f32x4){0.f, 0.f, 0.f, 0.f}; }
#pragma unroll
    for (int kk = 0; kk < 2; ++kk) {
#pragma unroll
        for (int mt = 0; mt < 8; ++mt) {
            const bf16x8 a = *(const LAS bf16x8*)(kT + (mt * 16 + fr) * 144 + (kk * 32 + fq * 8) * 2);
#pragma unroll
            for (int n = 0; n < 2; ++n) acc[mt][n] = __builtin_amdgcn_mfma_f32_16x16x32_bf16(a, bv[kk][n], acc[mt][n], 0, 0, 0);
        }
    }
    if (c < 256) {
        u16* ut = (u16*)(ws + WS_UT) + (size_t)(c * 4 + h) * 32768;
#pragma unroll
        for (int mt = 0; mt < 8; ++mt)
#pragma unroll
            for (int n = 0; n < 2; ++n) {
                u32x2 wv; wv.x = cvt_pk_bf16(acc[mt][n][0], acc[mt][n][1]); wv.y = cvt_pk_bf16(acc[mt][n][2], acc[mt][n][3]);
                *(u32x2*)(ut + (w * 32 + n * 16 + fr) * 128 + mt * 16 + fq * 4) = wv;
            }
    } else {
        const int s = c - 256;
        const size_t sidx = (((size_t)l * 8 + s) * 4 + h) * 32768;
        const float* s0 = p.state_gla + sidx;
        float* so = p.out + OFF_GSS + sidx;
        u16* sp = (u16*)(ws + WS_SP) + (size_t)(c * 4 + h) * 32768;
#pragma unroll
        for (int mt = 0; mt < 8; ++mt)
#pragma unroll
            for (int n = 0; n < 2; ++n) {
                const int dv = w * 32 + n * 16 + fr, dk0 = mt * 16 + fq * 4;
                float sv[4];
#pragma unroll
                for (int e = 0; e < 4; ++e) { sv[e] = s0[(dk0 + e) * 256 + dv]; so[(dk0 + e) * 256 + dv] = decl[dk0 + e] * sv[e] + acc[mt][n][e]; }
                u32x2 wv; wv.x = cvt_pk_bf16(sv[0], sv[1]); wv.y = cvt_pk_bf16(sv[2], sv[3]);
                *(u32x2*)(sp + dv * 128 + dk0) = wv;
            }
    }
    __syncthreads();
}

__device__ __forceinline__ void scan_task(const Params& p, int l, int j, LAS unsigned char* lds) {
    unsigned char* ws = p.ws;
    int tid = threadIdx.x; asm volatile("" : "+v"(tid)); asm volatile("" : "+s"(l));
    const int e = j * 2048 + tid * 4;
    const int h = e >> 15, dk = e & 127, dv = (e >> 7) & 255;
    const u16* ut = (const u16*)(ws + WS_UT) + e; u16* sp = (u16*)(ws + WS_SP) + e;
    LAS float* dl = (LAS float*)lds;
    {
        const float* dsrc = (const float*)(ws + WS_DEC) + h * 128;
#pragma unroll
        for (int i = 0; i < 16; ++i) { const int q = tid + i * 512, c = q >> 5, d4 = (q & 31) * 4; *(LAS f32x4*)(dl + c * 128 + d4) = *(const f32x4*)(dsrc + (size_t)c * 512 + d4); }
    }
    f32x4 S = (f32x4){0.f, 0.f, 0.f, 0.f};
    u32x2 uvA[16], uvB[16];
#define SCAN_LOAD(uv, cb) do { _Pragma("unroll") for (int i = 0; i < 16; ++i) uv[i] = *(const u32x2*)(ut + (size_t)((cb) + i) * 131072); } while (0)
#define SCAN_STEP(uv, cb) do { _Pragma("unroll") for (int i = 0; i < 16; ++i) { \
            const f32x4 dd = *(const LAS f32x4*)(dl + ((cb) + i) * 128 + dk); \
            u32x2 wv; wv.x = cvt_pk_bf16(S[0], S[1]); wv.y = cvt_pk_bf16(S[2], S[3]); \
            *(u32x2*)(sp + (size_t)((cb) + i) * 131072) = wv; \
            S[0] = dd[0] * S[0] + bflo(uv[i].x); S[1] = dd[1] * S[1] + bfhi(uv[i].x); \
            S[2] = dd[2] * S[2] + bflo(uv[i].y); S[3] = dd[3] * S[3] + bfhi(uv[i].y); } } while (0)
    SCAN_LOAD(uvA, 0);
    __syncthreads();
    for (int c0 = 0; c0 < 256; c0 += 32) {
        SCAN_LOAD(uvB, c0 + 16);
        SCAN_STEP(uvA, c0);
        if (c0 + 32 < 256) SCAN_LOAD(uvA, c0 + 32);
        SCAN_STEP(uvB, c0 + 16);
    }
#undef SCAN_LOAD
#undef SCAN_STEP
    float* go = p.out + OFF_GSP + ((size_t)l * 4 + h) * 32768 + dk * 256 + dv;
#pragma unroll
    for (int i = 0; i < 4; ++i) go[i * 256] = S[i];
}

template <bool SMP>
__device__ __forceinline__ void gla_out_item(const Params& p, int l, int c, int h, LAS unsigned char* lds) {
    int tid = threadIdx.x; asm volatile("" : "+v"(tid)); asm volatile("" : "+s"(l));
    const int lane = tid & 63, w = tid >> 6, fr = lane & 15, fq = lane >> 4, d = tid & 127, tg = tid >> 7;
    unsigned char* ws = p.ws;
    LAS float* red = (LAS float*)(lds + 2048);
    LAS unsigned char* Q = lds + 4096;
    LAS unsigned char* Kt = Q + 17408;
    LAS unsigned char* P = Kt + 17408;
    const int tok0 = c * 64;
    const size_t rowoff = (size_t)(tok0 + tg * 16) * 512 + h * 128 + d;
    const float* bc = (const float*)(ws + WS_BCUM) + rowoff;
    const u16* qp = (const u16*)(ws + WS_ZQ) + rowoff;
    const u16* kp = (const u16*)(ws + WS_ZK) + rowoff;
    float b[16]; u16 qraw[16], kraw[16];
    const int t8 = tid >> 3, dg = (tid & 7) * 16;
    u32x4 qw0, qw1, kw0, kw1, ew0, ew1;
    if (!SMP) {
        const size_t ro = (size_t)(tok0 + t8) * 512 + h * 128 + dg;
        qw0 = *(const u32x4*)((const u16*)(ws + WS_ZQ) + ro); qw1 = *(const u32x4*)((const u16*)(ws + WS_ZQ) + ro + 8);
        kw0 = *(const u32x4*)((const u16*)(ws + WS_ZK) + ro); kw1 = *(const u32x4*)((const u16*)(ws + WS_ZK) + ro + 8);
        ew0 = *(const u32x4*)((const u16*)(ws + WS_BCUM) + ro); ew1 = *(const u32x4*)((const u16*)(ws + WS_BCUM) + ro + 8);
    } else {
#pragma unroll
        for (int i = 0; i < 16; ++i) { qraw[i] = qp[i * 512]; kraw[i] = kp[i * 512]; }
    }
    const u16* vt = (const u16*)(ws + WS_ZVT) + (size_t)(h * 256 + w * 32 + fr) * T + tok0 + fq * 8;
    bf16x8 bv[2][2];
#pragma unroll
    for (int kk = 0; kk < 2; ++kk)
#pragma unroll
        for (int n = 0; n < 2; ++n) bv[kk][n] = *(const bf16x8*)(vt + (size_t)(n * 16) * T + kk * 32);
    const u16* sp = (const u16*)(ws + WS_SP) + (size_t)(c * 4 + h) * 32768 + (size_t)(w * 32 + fr) * 128 + fq * 8;
    bf16x8 bs[4][2];
    if (!SMP) {
#pragma unroll
        for (int kk = 0; kk < 4; ++kk)
#pragma unroll
            for (int n = 0; n < 2; ++n) bs[kk][n] = *(const bf16x8*)(sp + n * 16 * 128 + kk * 32);
    } else {
        const float* s0 = p.state_gla + (((size_t)l * 8 + (c - 256)) * 4 + h) * 32768 + w * 32 + fr;
#pragma unroll
        for (int kk = 0; kk < 4; ++kk)
#pragma unroll
            for (int n = 0; n < 2; ++n) {
                float sv[8];
#pragma unroll
                for (int j = 0; j < 8; ++j) sv[j] = s0[(size_t)(kk * 32 + fq * 8 + j) * 256 + n * 16];
                u32x4 pw; pw.x = cvt_pk_bf16(sv[0], sv[1]); pw.y = cvt_pk_bf16(sv[2], sv[3]); pw.z = cvt_pk_bf16(sv[4], sv[5]); pw.w = cvt_pk_bf16(sv[6], sv[7]);
                bs[kk][n] = __builtin_bit_cast(bf16x8, pw);
            }
    }
    u32x2 gav[4][2];
#pragma unroll
    for (int mt = 0; mt < 4; ++mt)
#pragma unroll
        for (int n = 0; n < 2; ++n) gav[mt][n] = *(const u32x2*)((const u16*)(ws + WS_ZGA) + (size_t)(tok0 + mt * 16 + fr) * 1024 + h * 256 + w * 32 + n * 16 + fq * 4);
    if (SMP) {
        float blast; gla_gates(p, l, h, tok0, d, tg, (LAS float*)lds, b, blast);
#pragma unroll
        for (int i = 0; i < 16; ++i) {
            const int t = tg * 16 + i;
            const float qv = bf2f(qraw[i]) * 0.08838834764831845f * __expf(b[i]);
            const float kv = bf2f(kraw[i]) * __expf(-b[i]);
            ((LAS u16*)Q)[t * 136 + d] = f2bf(qv); ((LAS u16*)Kt)[t * 136 + d] = f2bf(kv);
        }
    } else {
        const unsigned qq[8] = {qw0.x, qw0.y, qw0.z, qw0.w, qw1.x, qw1.y, qw1.z, qw1.w};
        const unsigned kk8[8] = {kw0.x, kw0.y, kw0.z, kw0.w, kw1.x, kw1.y, kw1.z, kw1.w};
        const unsigned ee[8] = {ew0.x, ew0.y, ew0.z, ew0.w, ew1.x, ew1.y, ew1.z, ew1.w};
        unsigned qo[8], ko[8];
#pragma unroll
        for (int j = 0; j < 8; ++j) {
            const float e0 = bflo(ee[j]), e1 = bfhi(ee[j]);
            const float q0 = bflo(qq[j]) * 0.08838834764831845f * e0, q1 = bfhi(qq[j]) * 0.08838834764831845f * e1;
            const float k0 = bflo(kk8[j]) * __builtin_amdgcn_rcpf(e0), k1 = bfhi(kk8[j]) * __builtin_amdgcn_rcpf(e1);
            qo[j] = cvt_pk_bf16(q0, q1); ko[j] = cvt_pk_bf16(k0, k1);
        }
        u32x4 w0, w1; w0.x = qo[0]; w0.y = qo[1]; w0.z = qo[2]; w0.w = qo[3]; w1.x = qo[4]; w1.y = qo[5]; w1.z = qo[6]; w1.w = qo[7];
        *(LAS u32x4*)(Q + t8 * 272 + dg * 2) = w0; *(LAS u32x4*)(Q + t8 * 272 + dg * 2 + 16) = w1;
        w0.x = ko[0]; w0.y = ko[1]; w0.z = ko[2]; w0.w = ko[3]; w1.x = ko[4]; w1.y = ko[5]; w1.z = ko[6]; w1.w = ko[7];
        *(LAS u32x4*)(Kt + t8 * 272 + dg * 2) = w0; *(LAS u32x4*)(Kt + t8 * 272 + dg * 2 + 16) = w1;
    }
    __syncthreads();
    {
        const int mt = w >> 1;
#pragma unroll
        for (int j = 0; j < 2; ++j) {
            const int nt = (w & 1) * 2 + j;
            f32x4 s = (f32x4){0.f, 0.f, 0.f, 0.f};
            if (nt <= mt) {
#pragma unroll
                for (int kk = 0; kk < 4; ++kk) {
                    const bf16x8 a = *(const LAS bf16x8*)(Q + (mt * 16 + fr) * 272 + (kk * 32 + fq * 8) * 2);
                    const bf16x8 bq = *(const LAS bf16x8*)(Kt + (nt * 16 + fr) * 272 + (kk * 32 + fq * 8) * 2);
                    s = __builtin_amdgcn_mfma_f32_16x16x32_bf16(a, bq, s, 0, 0, 0);
                }
            }
#pragma unroll
            for (int e = 0; e < 4; ++e) { const int t = mt * 16 + fq * 4 + e, si = nt * 16 + fr; ((LAS u16*)P)[t * 72 + si] = f2bf(si <= t ? s[e] : 0.f); }
        }
    }
    __syncthreads();
    f32x4 o[4][2];
#pragma unroll
    for (int mt = 0; mt < 4; ++mt) { o[mt][0] = (f32x4){0.f, 0.f, 0.f, 0.f}; o[mt][1] = (f32x4){0.f, 0.f, 0.f, 0.f}; }
#pragma unroll
    for (int kk = 0; kk < 2; ++kk) {
#pragma unroll
        for (int mt = 0; mt < 4; ++mt) {
            if (2 * kk <= mt) {
                const bf16x8 a = *(const LAS bf16x8*)(P + (mt * 16 + fr) * 144 + (kk * 32 + fq * 8) * 2);
#pragma unroll
                for (int n = 0; n < 2; ++n) o[mt][n] = __builtin_amdgcn_mfma_f32_16x16x32_bf16(bv[kk][n], a, o[mt][n], 0, 0, 0);
            }
        }
    }
#pragma unroll
    for (int kk = 0; kk < 4; ++kk) {
#pragma unroll
        for (int mt = 0; mt < 4; ++mt) {
            const bf16x8 a = *(const LAS bf16x8*)(Q + (mt * 16 + fr) * 272 + (kk * 32 + fq * 8) * 2);
#pragma unroll
            for (int n = 0; n < 2; ++n) o[mt][n] = __builtin_amdgcn_mfma_f32_16x16x32_bf16(bs[kk][n], a, o[mt][n], 0, 0, 0);
        }
    }
#pragma unroll
    for (int mt = 0; mt < 4; ++mt) {
        float s2 = 0.f;
#pragma unroll
        for (int n = 0; n < 2; ++n)
#pragma unroll
            for (int e = 0; e < 4; ++e) s2 += o[mt][n][e] * o[mt][n][e];
        s2 += __shfl_xor(s2, 16); s2 += __shfl_xor(s2, 32);
        if (fq == 0) red[w * 64 + mt * 16 + fr] = s2;
    }
    __syncthreads();
    const float* gn = p.gla_norm_g + l * 256 + w * 32 + fq * 4;
    const f32x4 g0 = *(const f32x4*)gn, g1 = *(const f32x4*)(gn + 16);
#pragma unroll
    for (int mt = 0; mt < 4; ++mt) {
        const int t = mt * 16 + fr;
        float tot = 0.f;
#pragma unroll
        for (int ww = 0; ww < 8; ++ww) tot += red[ww * 64 + t];
        const float rs = rsqrtf(tot * (1.f / 256.f) + EPS);
#pragma unroll
        for (int n = 0; n < 2; ++n) {
            const f32x4 gg = n ? g1 : g0; const u32x2 ga = gav[mt][n];
            const float o0 = o[mt][n][0] * rs * gg[0] * silu(bflo(ga.x)), o1 = o[mt][n][1] * rs * gg[1] * silu(bfhi(ga.x));
            const float o2 = o[mt][n][2] * rs * gg[2] * silu(bflo(ga.y)), o3 = o[mt][n][3] * rs * gg[3] * silu(bfhi(ga.y));
            u32x2 wv; wv.x = cvt_pk_bf16(o0, o1); wv.y = cvt_pk_bf16(o2, o3);
            *(u32x2*)((u16*)(ws + WS_OBUF) + (size_t)(tok0 + t) * 2048 + h * 256 + w * 32 + n * 16 + fq * 4) = wv;
        }
    }
    __syncthreads();
}

__device__ __forceinline__ void lr_item(const Params& p, int l, int c, LAS unsigned char* lds) {
    int tid = threadIdx.x; asm volatile("" : "+v"(tid)); asm volatile("" : "+s"(l));
    const int lane = tid & 63, w = tid >> 6, fr = lane & 15, fq = lane >> 4;
    unsigned char* ws = p.ws;
    const u16* xb = (const u16*)(ws + WS_XB) + (size_t)(c * 64) * 2048 + w * 256 + fq * 8;
    const u16* wl = (const u16*)(ws + WS_WTIN) + ((size_t)l * NZROWS + 6144 + fr) * 2048 + w * 256 + fq * 8;
    f32x4 acc[4];
#pragma unroll
    for (int mt = 0; mt < 4; ++mt) acc[mt] = (f32x4){0.f, 0.f, 0.f, 0.f};
#pragma unroll
    for (int kk = 0; kk < 8; ++kk) {
        const bf16x8 bw = *(const bf16x8*)(wl + kk * 32);
#pragma unroll
        for (int mt = 0; mt < 4; ++mt) {
            const bf16x8 a = *(const bf16x8*)(xb + (size_t)(mt * 16 + fr) * 2048 + kk * 32);
            acc[mt] = __builtin_amdgcn_mfma_f32_16x16x32_bf16(a, bw, acc[mt], 0, 0, 0);
        }
    }
    LAS float* red = (LAS float*)lds;
#pragma unroll
    for (int mt = 0; mt < 4; ++mt)
#pragma unroll
        for (int e = 0; e < 4; ++e) red[w * 1024 + (mt * 16 + fq * 4 + e) * 16 + fr] = acc[mt][e];
    __syncthreads();
    {
        const int o = tid * 2, t = o >> 4;
        float s0 = 0.f, s1 = 0.f;
#pragma unroll
        for (int ww = 0; ww < 8; ++ww) { s0 += red[ww * 1024 + o]; s1 += red[ww * 1024 + o + 1]; }
        const float rs = rstd_of(((const u64*)(ws + WS_SUMSQ))[(size_t)l * T + c * 64 + t]);
        float* zl = (float*)(ws + WS_ZLR) + (size_t)(c * 64) * 16 + o;
        zl[0] = s0 * rs; zl[1] = s1 * rs;
    }
    __syncthreads();
}

__device__ __forceinline__ void gla_sample_state_item(const Params& p, int l, int sidx4, LAS unsigned char* lds) {
    int tid = threadIdx.x; asm volatile("" : "+v"(tid)); asm volatile("" : "+s"(l));
    const int lane = tid & 63, wv = tid >> 6, fr = lane & 15, fq = lane >> 4, d = tid & 127, tg = tid >> 7;
    const int s = sidx4 >> 2, h = sidx4 & 3, tok0 = TP + s * 64;
    unsigned char* ws = p.ws;
    LAS float* gs = (LAS float*)(lds + 8192);
    LAS float* dl = (LAS float*)(lds + 8192 + 2048);
    LAS unsigned char* kt = lds + 16384;
    const u16* kp = (const u16*)(ws + WS_ZK) + (size_t)(tok0 + tg * 16) * 512 + h * 128 + d;
    u16 kr[16];
#pragma unroll
    for (int i = 0; i < 16; ++i) kr[i] = kp[i * 512];
    float b[16], blast;
    gla_gates(p, l, h, tok0, d, tg, gs, b, blast);
#pragma unroll
    for (int i = 0; i < 16; ++i) ((LAS u16*)kt)[d * 72 + tg * 16 + i] = f2bf(bf2f(kr[i]) * __expf(blast - b[i]));
    if (tg == 0) dl[d] = __expf(blast);
    __syncthreads();
    const u16* vt = (const u16*)(ws + WS_ZVT) + (size_t)(h * 256 + wv * 32 + fr) * T + tok0 + fq * 8;
    const size_t so_off = (((size_t)l * 8 + s) * 4 + h) * 32768;
    const float* s0 = p.state_gla + so_off;
    float* so = p.out + OFF_GSS + so_off;
#pragma unroll
    for (int n = 0; n < 2; ++n) {
        const bf16x8 v0 = *(const bf16x8*)(vt + (size_t)(n * 16) * T), v1 = *(const bf16x8*)(vt + (size_t)(n * 16) * T + 32);
        const int dv = wv * 32 + n * 16 + fr;
#pragma unroll
        for (int mt = 0; mt < 8; ++mt) {
            f32x4 a = (f32x4){0.f, 0.f, 0.f, 0.f};
            const bf16x8 k0 = *(const LAS bf16x8*)(kt + (mt * 16 + fr) * 144 + (fq * 8) * 2), k1 = *(const LAS bf16x8*)(kt + (mt * 16 + fr) * 144 + (32 + fq * 8) * 2);
            a = __builtin_amdgcn_mfma_f32_16x16x32_bf16(k0, v0, a, 0, 0, 0);
            a = __builtin_amdgcn_mfma_f32_16x16x32_bf16(k1, v1, a, 0, 0, 0);
            const int dk0 = mt * 16 + fq * 4;
#pragma unroll
            for (int e = 0; e < 4; ++e) so[(dk0 + e) * 256 + dv] = dl[dk0 + e] * s0[(dk0 + e) * 256 + dv] + a[e];
        }
    }
    __syncthreads();
}

__device__ __forceinline__ void gmlp_item(const Params& p, int l, int mc, int g, LAS unsigned char* lds) {
    int tid = threadIdx.x; asm volatile("" : "+v"(tid)); asm volatile("" : "+s"(l));
    const int lane = tid & 63, w = tid >> 6, fr = lane & 15, fq = lane >> 4;
    unsigned char* ws = p.ws;
    LAS float* rsum = (LAS float*)lds;
    LAS float* rsq = (LAS float*)(lds + 2048);
    LAS unsigned char* Vn = lds + 4096;
    LAS float* lnp = (LAS float*)(lds + 4096 + 69632);
    lnp[tid] = (tid < 256) ? p.mlp_ln_g[l * 1024 + g * 256 + tid] : p.mlp_ln_b[l * 1024 + g * 256 + tid - 256];
    const bool smp = mc >= 128;
    const int ntok = smp ? 64 : 128, tok0 = smp ? TP + (mc - 128) * 64 : mc * 128;
    const int tk = tid & 127, cq = tid >> 7; const bool active = tk < ntok;
    const int oct = tid & 15, row0 = tid >> 4; const bool act8 = oct * 8 < ntok;
    LAS float* part = (LAS float*)(lds + 77824);
    LAS float* stat = (LAS float*)(lds + 77824 + 8192);
    u32x4 raw[8];
    {
        const u16* vp = (const u16*)(ws + WS_ZVMT) + (size_t)(g * 256 + row0) * T + tok0 + oct * 8;
#pragma unroll
        for (int i = 0; i < 8; ++i) raw[i] = act8 ? *(const u32x4*)(vp + (size_t)(32 * i) * T) : (u32x4){0u, 0u, 0u, 0u};
    }
    {
        float ps[8], pq[8];
#pragma unroll
        for (int j = 0; j < 8; ++j) { ps[j] = 0.f; pq[j] = 0.f; }
#pragma unroll
        for (int i = 0; i < 8; ++i) {
            const float x0 = bflo(raw[i].x), x1 = bfhi(raw[i].x), x2 = bflo(raw[i].y), x3 = bfhi(raw[i].y), x4 = bflo(raw[i].z), x5 = bfhi(raw[i].z), x6 = bflo(raw[i].w), x7 = bfhi(raw[i].w);
            ps[0] += x0; pq[0] += x0 * x0; ps[1] += x1; pq[1] += x1 * x1; ps[2] += x2; pq[2] += x2 * x2; ps[3] += x3; pq[3] += x3 * x3;
            ps[4] += x4; pq[4] += x4 * x4; ps[5] += x5; pq[5] += x5 * x5; ps[6] += x6; pq[6] += x6 * x6; ps[7] += x7; pq[7] += x7 * x7;
        }
#pragma unroll
        for (int j = 0; j < 8; ++j) { ps[j] += __shfl_xor(ps[j], 16); ps[j] += __shfl_xor(ps[j], 32); pq[j] += __shfl_xor(pq[j], 16); pq[j] += __shfl_xor(pq[j], 32); }
        if (lane < 16) {
#pragma unroll
            for (int j = 0; j < 8; ++j) { part[(w * 128 + oct * 8 + j) * 2] = ps[j]; part[(w * 128 + oct * 8 + j) * 2 + 1] = pq[j]; }
        }
    }
    __syncthreads();
    if (tid < 128) {
        float S = 0.f, S2 = 0.f;
#pragma unroll
        for (int ww = 0; ww < 8; ++ww) { S += part[(ww * 128 + tid) * 2]; S2 += part[(ww * 128 + tid) * 2 + 1]; }
        const float mu = S * (1.f / 256.f), var = fmaxf(S2 * (1.f / 256.f) - mu * mu, 0.f);
        stat[tid * 2] = mu; stat[tid * 2 + 1] = rsqrtf(var + EPS);
    }
    __syncthreads();
    {
        float mu[8], rs[8];
#pragma unroll
        for (int j = 0; j < 8; ++j) { mu[j] = stat[(oct * 8 + j) * 2]; rs[j] = stat[(oct * 8 + j) * 2 + 1]; }
        float* mvs = p.out + OFF_MVS + (((size_t)l * 8 + (mc - 128)) * 64 + oct * 8) * 1024 + g * 256;
#pragma unroll
        for (int i = 0; i < 8; ++i) {
            const int c = row0 + 32 * i; const float gg = lnp[c], bb = lnp[256 + c];
            float vn[8];
            vn[0] = (bflo(raw[i].x) - mu[0]) * rs[0] * gg + bb; vn[1] = (bfhi(raw[i].x) - mu[1]) * rs[1] * gg + bb;
            vn[2] = (bflo(raw[i].y) - mu[2]) * rs[2] * gg + bb; vn[3] = (bfhi(raw[i].y) - mu[3]) * rs[3] * gg + bb;
            vn[4] = (bflo(raw[i].z) - mu[4]) * rs[4] * gg + bb; vn[5] = (bfhi(raw[i].z) - mu[5]) * rs[5] * gg + bb;
            vn[6] = (bflo(raw[i].w) - mu[6]) * rs[6] * gg + bb; vn[7] = (bfhi(raw[i].w) - mu[7]) * rs[7] * gg + bb;
            u32x4 wv = (u32x4){0u, 0u, 0u, 0u};
            if (act8) {
                wv.x = cvt_pk_bf16(vn[0], vn[1]); wv.y = cvt_pk_bf16(vn[2], vn[3]); wv.z = cvt_pk_bf16(vn[4], vn[5]); wv.w = cvt_pk_bf16(vn[6], vn[7]);
                if (smp) {
#pragma unroll
                    for (int j = 0; j < 8; ++j) mvs[(size_t)j * 1024 + c] = vn[j];
                }
            }
            *(LAS u32x4*)(Vn + c * 272 + oct * 16) = wv;
        }
    }
    __syncthreads();
    const int ntt = ntok >> 4;
    f32x4 acc[2][8];
#pragma unroll
    for (int tt = 0; tt < 8; ++tt) { acc[0][tt] = (f32x4){0.f, 0.f, 0.f, 0.f}; acc[1][tt] = (f32x4){0.f, 0.f, 0.f, 0.f}; }
    const u16* wsb = (const u16*)(ws + WS_WSB) + (size_t)(l * 4 + g) * 128 * 128;
#pragma unroll
    for (int kk = 0; kk < 4; ++kk) {
        bf16x8 a[2];
#pragma unroll
        for (int ct = 0; ct < 2; ++ct) a[ct] = *(const LAS bf16x8*)(Vn + (w * 32 + ct * 16 + fr) * 272 + (kk * 32 + fq * 8) * 2);
#pragma unroll
        for (int tt = 0; tt < 8; ++tt) {
            if ((tt >> 1) >= kk && tt < ntt) {
                const bf16x8 bw = *(const bf16x8*)(wsb + (tt * 16 + fr) * 128 + kk * 32 + fq * 8);
#pragma unroll
                for (int ct = 0; ct < 2; ++ct) acc[ct][tt] = __builtin_amdgcn_mfma_f32_16x16x32_bf16(a[ct], bw, acc[ct][tt], 0, 0, 0);
            }
        }
    }
    const float* bsp = p.b_s + (size_t)(l * 4 + g) * 128;
#pragma unroll
    for (int tt = 0; tt < 8; ++tt) {
        if (tt < ntt) {
            const int tok = tok0 + tt * 16 + fr; const float bs = bsp[tt * 16 + fr];
#pragma unroll
            for (int ct = 0; ct < 2; ++ct) {
                const int cb = g * 256 + w * 32 + ct * 16 + fq * 4;
                const u32x2 uu = *(const u32x2*)((const u16*)(ws + WS_ZU) + (size_t)tok * 1024 + cb);
                const u32x2 gg = *(const u32x2*)((const u16*)(ws + WS_ZGB) + (size_t)tok * 1024 + cb);
                const float o0 = bflo(uu.x) * (acc[ct][tt][0] + bs) * silu(bflo(gg.x));
                const float o1 = bfhi(uu.x) * (acc[ct][tt][1] + bs) * silu(bfhi(gg.x));
                const float o2 = bflo(uu.y) * (acc[ct][tt][2] + bs) * silu(bflo(gg.y));
                const float o3 = bfhi(uu.y) * (acc[ct][tt][3] + bs) * silu(bfhi(gg.y));
                u32x2 wv; wv.x = cvt_pk_bf16(o0, o1); wv.y = cvt_pk_bf16(o2, o3);
                *(u32x2*)((u16*)(ws + WS_OBUF) + (size_t)tok * 2048 + 1024 + cb) = wv;
            }
        }
    }
    __syncthreads();
}

__device__ __forceinline__ void phase_final(const Params& p) {
    int tid = threadIdx.x; asm volatile("" : "+v"(tid));
    const int lane = tid & 63, wid = tid >> 6;
    const u16* xb = (const u16*)(p.ws + WS_XB);
    const u64* ss = (const u64*)(p.ws + WS_SUMSQ) + (size_t)4 * T;
    for (int row = blockIdx.x * 8 + wid; row < T; row += gridDim.x * 8) {
        const float rs = rstd_of(ss[row]);
#pragma unroll
        for (int j = 0; j < 4; ++j) {
            const u32x4 xw = *(const u32x4*)(xb + (size_t)row * 2048 + j * 512 + lane * 8);
            const f32x4 g0 = *(const f32x4*)(p.final_norm_g + j * 512 + lane * 8), g1 = *(const f32x4*)(p.final_norm_g + j * 512 + lane * 8 + 4);
            float* o = p.out + OFF_Y + (size_t)row * 2048 + j * 512 + lane * 8;
            *(f32x4*)o = (f32x4){bflo(xw.x), bfhi(xw.x), bflo(xw.y), bfhi(xw.y)} * rs * g0;
            *(f32x4*)(o + 4) = (f32x4){bflo(xw.z), bfhi(xw.z), bflo(xw.w), bfhi(xw.w)} * rs * g1;
        }
    }
}

#define XB_TMO      128
#define XB_XCNT(j)  (256  + 64 * (j))
#define XB_XSUB(j)  (1280 + 64 * (j))
#define XB_XGEN(j)  (2304 + 64 * (j))
#define XB_TOP      3328
#define XB_TOPGEN   3392
#define XB_QUEUE    3520
#define XB_SPIN_CAP (1u << 20)
__device__ __forceinline__ unsigned xb_ld(unsigned* p)              { return __hip_atomic_load(p, __ATOMIC_RELAXED, __HIP_MEMORY_SCOPE_AGENT); }
__device__ __forceinline__ unsigned xb_add(unsigned* p, unsigned v) { return __hip_atomic_fetch_add(p, v, __ATOMIC_RELAXED, __HIP_MEMORY_SCOPE_AGENT); }
__device__ __forceinline__ unsigned xb_xcc_id() { return (unsigned)__builtin_amdgcn_s_getreg((3 << 11) | 20) & 0xFu; }
#define XB_SPIN(cond, bar) do { unsigned _sp = 0; while (cond) { __builtin_amdgcn_s_sleep(1); \
    if ((++_sp & 255u) == 0u) { if (xb_ld(&(bar)[XB_TMO])) break; if (_sp > XB_SPIN_CAP) { atomicAdd(&(bar)[XB_TMO], 1u); break; } } } } while (0)
struct XcdBarrier { unsigned* bar; unsigned x; volatile LAS unsigned* st; };
__device__ __forceinline__ void xcd_barrier_complete(unsigned* bar, unsigned x, unsigned& nloc, unsigned& nx) {
    const unsigned G = gridDim.x;
    unsigned sum, cnt, mine, sp = 0u;
    for (;;) {
        sum = 0u; cnt = 0u; mine = 0u;
#pragma unroll
        for (unsigned j = 0; j < 16; ++j) { const unsigned c = xb_ld(&bar[XB_XCNT(j)]); sum += c; cnt += (c > 0u) ? 1u : 0u; mine = (j == x) ? c : mine; }
        if (sum == G) break;
        __builtin_amdgcn_s_sleep(1);
        if ((++sp & 255u) == 0u) { if (xb_ld(&bar[XB_TMO])) break; if (sp > XB_SPIN_CAP) { atomicAdd(&bar[XB_TMO], 1u); break; } }
    }
    nloc = mine > 0u ? mine : 1u; nx = cnt > 0u ? cnt : 1u;
}
__device__ __forceinline__ void grid_barrier(const XcdBarrier& b) {
    asm volatile("s_waitcnt vmcnt(0)" ::: "memory");
    __syncthreads();
    if (threadIdx.x == 0) {
        unsigned* bar = b.bar;
        __builtin_amdgcn_s_waitcnt(0);
        unsigned nloc = b.st[0], nx = b.st[1];
        if (nloc == 0u) { xcd_barrier_complete(bar, b.x, nloc, nx); b.st[0] = nloc; b.st[1] = nx; }
        const unsigned old = xb_add(&bar[XB_XSUB(b.x)], 1u);
        const unsigned gen = old / nloc;
        if (old + 1u == (gen + 1u) * nloc) {
            __builtin_amdgcn_fence(__ATOMIC_RELEASE, "agent");
            asm volatile("s_waitcnt vmcnt(0)" ::: "memory");
            const unsigned og = xb_add(&bar[XB_TOP], 1u);
            const unsigned tg = og / nx;
            if (og + 1u == (tg + 1u) * nx) xb_add(&bar[XB_TOPGEN], 1u);
            else XB_SPIN(xb_ld(&bar[XB_TOPGEN]) == tg, bar);
            __builtin_amdgcn_fence(__ATOMIC_ACQUIRE, "agent");
            xb_add(&bar[XB_XGEN(b.x)], 1u);
            asm volatile("s_waitcnt vmcnt(0)" ::: "memory");
        } else {
            XB_SPIN(xb_ld(&bar[XB_XGEN(b.x)]) == gen, bar);
            __builtin_amdgcn_fence(__ATOMIC_ACQUIRE, "agent");
            asm volatile("s_waitcnt vmcnt(0)" ::: "memory");
        }
    }
    __syncthreads();
}

__device__ __forceinline__ int queue_next(unsigned* ctr, LAS int* slot) {
    __syncthreads();
    if (threadIdx.x == 0) *slot = (int)__hip_atomic_fetch_add(ctr, 1u, __ATOMIC_RELAXED, __HIP_MEMORY_SCOPE_AGENT);
    __syncthreads();
    return *slot;
}

__global__ void __launch_bounds__(NTHREADS) fwd_megakernel(Params p) {
    extern __shared__ __attribute__((aligned(16))) unsigned char lds_raw[];
    LAS unsigned char* lds = (LAS unsigned char*)lds_raw;
    cg::grid_group grid = cg::this_grid();
    unsigned* bar = (unsigned*)(p.ws + WS_BAR);
    LAS int* qslot = (LAS int*)(lds + 131072);
    XcdBarrier xb; xb.bar = bar; xb.x = xb_xcc_id(); xb.st = (volatile LAS unsigned*)(lds + 131072 + 16);
    if (threadIdx.x == 0) { xb.st[0] = 0u; xb.st[1] = 0u; (void)xb_add(&bar[XB_XCNT(xb.x)], 1u); }
    __syncthreads();
    grid.sync();
    phase_prep(p, lds);
    if (PROBE_DUP & 1) { grid_barrier(xb); phase_prep(p, lds); }
    grid_barrier(xb);
#pragma unroll 1
    for (int l = 0; l < DEPTH; ++l) {
        const int bx = blockIdx.x;
        {
            const int grp = (bx >> 3) & 1;
#pragma unroll 1
            for (int pass = 0; pass < 2; ++pass) {
                if (pass == grp) for (int c = bx; c < 256; c += gridDim.x) lr_item(p, l, c, lds);
                if (pass == 0) gemm_phase<0>(lds, p, l, -1);
            }
        }
        grid_barrier(xb);
#pragma unroll 1
        for (int sub = 0; sub < 2; ++sub) {
            int start, hi, step;
            if (sub == 0) {
                if (bx < 48) gemm_phase<0>(lds, p, l, bx);
                else if (bx < 56) lr_item(p, l, 256 + bx - 48, lds);
                hi = 832; step = 208; start = (bx < 48) ? hi : bx - 48;
            } else {
                hi = 1024; step = 256; start = (bx >= 48) ? 832 + bx - 48 : hi;
                asm volatile("s_waitcnt vmcnt(0)" ::: "memory");
                __syncthreads();
                if (threadIdx.x == 0) { __builtin_amdgcn_fence(__ATOMIC_ACQUIRE, "agent"); asm volatile("s_waitcnt vmcnt(0)" ::: "memory"); }
                __syncthreads();
            }
            for (int it = start; it < hi; it += step) gla_local_item(p, l, it >> 2, it & 3, lds);
        }
        grid_barrier(xb);
#pragma unroll 1
        for (int sub = 0; sub < 2; ++sub) {
            unsigned* qc = bar + XB_QUEUE + l * 8 + 2;
#pragma unroll 1
            for (int n = 0;; ++n) {
                int code;
                if (sub == 0) {
                    const int q = queue_next(qc, qslot);
                    if (q >= 496) break;
                    code = (q < 400) ? q : (q < 432 ? 64 + 512 + (q - 400) : (q < 464 ? 608 + (q - 432) : 640 + (q - 464)));
                } else {
                    if (bx < 16) { if (n > 0) break; code = 3000 + bx; }
                    else {
                        const int k = bx - 16;
                        if (n < 4) code = 1000 + k + 240 * n;
                        else if (n == 4) code = (k < 64) ? 1000 + k + 960 : 64 + 336 + (k - 64);
                        else break;
                    }
                }
                if (code < 64) scan_task(p, l, code, lds);
                else if (code < 608) gmlp_item(p, l, (code - 64) >> 2, (code - 64) & 3, lds);
                else if (code < 640) gla_out_item<true>(p, l, 256 + ((code - 608) >> 2), (code - 608) & 3, lds);
                else if (code < 672) gla_sample_state_item(p, l, code - 640, lds);
                else if (code < 3000) gla_out_item<false>(p, l, (code - 1000) >> 2, (code - 1000) & 3, lds);
                else gemm_phase<1>(lds, p, l, code - 3000);
            }
            grid_barrier(xb);
        }
        gemm_phase<1>(lds, p, l, -1);
        grid_barrier(xb);
    }
    phase_final(p);
}

extern "C" void kernel_launch(void* const* d_in, const int* in_sizes, int n_in, void* d_out, int out_size, void* d_ws, size_t ws_size, hipStream_t stream) {
    static int grid = 0;
    if (grid == 0) {
        if (n_in != 14 || ws_size < WS_END) { fprintf(stderr, "kernel_launch: unexpected n_in %d / ws_size %zu (need %zu)\n", n_in, ws_size, (size_t)WS_END); grid = -1; return; }
        int dev = 0, cus = 0, per_cu = 0;
        (void)hipGetDevice(&dev);
        (void)hipDeviceGetAttribute(&cus, hipDeviceAttributeMultiprocessorCount, dev);
        if (hipFuncSetAttribute((const void*)fwd_megakernel, hipFuncAttributeMaxDynamicSharedMemorySize, LDS_BYTES) != hipSuccess) { fprintf(stderr, "kernel_launch: hipFuncSetAttribute failed\n"); grid = -1; return; }
        (void)hipOccupancyMaxActiveBlocksPerMultiprocessor(&per_cu, (const void*)fwd_megakernel, NTHREADS, LDS_BYTES);
        (void)hipGetLastError();
        if (per_cu < 1) { fprintf(stderr, "kernel_launch: occupancy query says %d blocks per CU\n", per_cu); per_cu = 1; }
        grid = cus;
    }
    if (grid < 0) return;
    (void)hipMemsetAsync((unsigned char*)d_ws + WS_BAR, 0, 16384, stream);
    Params p{};
    p.x_prompt = (const float*)d_in[0]; p.x_sample = (const float*)d_in[1]; p.state_gla = (const float*)d_in[2]; p.w_in = (const float*)d_in[3];
    p.w_gate_up = (const float*)d_in[4]; p.b_gate = (const float*)d_in[5]; p.w_s = (const float*)d_in[6]; p.b_s = (const float*)d_in[7];
    p.norm_g = (const float*)d_in[8]; p.gla_norm_g = (const float*)d_in[9]; p.mlp_ln_g = (const float*)d_in[10]; p.mlp_ln_b = (const float*)d_in[11];
    p.w_out = (const float*)d_in[12]; p.final_norm_g = (const float*)d_in[13];
    p.out = (float*)d_out; p.ws = (unsigned char*)d_ws;
    void* args[] = {&p};
    hipError_t e = hipLaunchCooperativeKernel((const void*)fwd_megakernel, dim3(grid), dim3(NTHREADS), args, LDS_BYTES, stream);
    if (e != hipSuccess) fprintf(stderr, "cooperative launch failed: %s (grid %d)\n", hipGetErrorString(e), grid);
}
```

```cpp
#include <hip/hip_runtime.h>
#include <hip/hip_cooperative_groups.h>
#include <cstdio>
#include <cstdint>
namespace cg = cooperative_groups;

#define LAS __attribute__((address_space(3)))
typedef unsigned short u16;
typedef short bf16x8 __attribute__((ext_vector_type(8)));
typedef float f32x4 __attribute__((ext_vector_type(4)));
typedef unsigned u32x4 __attribute__((ext_vector_type(4)));
typedef unsigned u32x2 __attribute__((ext_vector_type(2)));

constexpr int T = 16896, TP = 16384, DM = 2048, DEPTH = 4, DIN = 6160;
constexpr int NZROWS = 6400;
constexpr int NCH = 264;
constexpr int NTHREADS = 512;
#ifndef PROBE_DUP
#define PROBE_DUP 0
#endif
constexpr int LDS_BYTES = 131072 + 256 + 1024;
constexpr float EPS = 1e-6f;
constexpr float SS_SCALE = 1048576.f, SS_INV = 1.f / (1048576.f * 2048.f);
typedef unsigned long long u64;
__device__ __forceinline__ float rstd_of(u64 s) { return rsqrtf((float)s * SS_INV + EPS); }

constexpr size_t AL(size_t x) { return (x + 255) & ~(size_t)255; }
constexpr size_t WS_WTIN = 0;
constexpr size_t WS_WTOUT = WS_WTIN + AL((size_t)DEPTH * NZROWS * 2048 * 2);
constexpr size_t WS_XRES = WS_WTOUT + AL((size_t)DEPTH * 2048 * 2048 * 2);
constexpr size_t WS_XB = WS_XRES + AL((size_t)T * 2048 * 4);
constexpr size_t WS_ZQ = WS_XB + AL((size_t)T * 2048 * 2);
constexpr size_t WS_ZK = WS_ZQ + AL((size_t)T * 512 * 2);
constexpr size_t WS_ZVT = WS_ZK + AL((size_t)T * 512 * 2);
constexpr size_t WS_ZGA = WS_ZVT + AL((size_t)T * 1024 * 2);
constexpr size_t WS_ZU = WS_ZGA + AL((size_t)T * 1024 * 2);
constexpr size_t WS_ZVMT = WS_ZU + AL((size_t)T * 1024 * 2);
constexpr size_t WS_ZGB = WS_ZVMT + AL((size_t)T * 1024 * 2);
constexpr size_t WS_ZLR = WS_ZGB + AL((size_t)T * 1024 * 2);
constexpr size_t WS_UT = WS_ZLR + AL((size_t)T * 16 * 4);
constexpr size_t WS_SP = WS_UT + AL((size_t)NCH * 4 * 32768 * 2);
constexpr size_t WS_DEC = WS_SP + AL((size_t)NCH * 4 * 32768 * 2);
constexpr size_t WS_OBUF = WS_DEC + AL((size_t)NCH * 4 * 128 * 4);
constexpr size_t WS_SUMSQ = WS_OBUF + AL((size_t)T * 2048 * 2);
constexpr size_t WS_BAR = WS_SUMSQ + AL((size_t)5 * T * 8);
constexpr size_t WS_BCUM = WS_BAR + 16384;
constexpr size_t WS_WSB = WS_BCUM + AL((size_t)T * 512 * 4);
constexpr size_t WS_END = WS_WSB + AL((size_t)DEPTH * 4 * 128 * 128 * 2);

constexpr size_t OFF_Y = 0;
constexpr size_t OFF_GSP = (size_t)T * 2048;
constexpr size_t OFF_GSS = OFF_GSP + (size_t)DEPTH * 4 * 32768;
constexpr size_t OFF_MVS = OFF_GSS + (size_t)DEPTH * 8 * 4 * 32768;

struct Params {
    const float *x_prompt, *x_sample, *state_gla, *w_in, *w_gate_up, *b_gate, *w_s, *b_s, *norm_g, *gla_norm_g, *mlp_ln_g, *mlp_ln_b, *w_out, *final_norm_g;
    float* out; unsigned char* ws;
};

__device__ __forceinline__ unsigned cvt_pk_bf16(float lo, float hi) { unsigned r; asm("v_cvt_pk_bf16_f32 %0, %1, %2" : "=v"(r) : "v"(lo), "v"(hi)); return r; }
__device__ __forceinline__ u16 f2bf(float f) { return (u16)(cvt_pk_bf16(f, 0.f) & 0xffffu); }
__device__ __forceinline__ float bf2f(u16 b) { return __uint_as_float(((unsigned)b) << 16); }
__device__ __forceinline__ float bflo(unsigned w) { return __uint_as_float(w << 16); }
__device__ __forceinline__ float bfhi(unsigned w) { return __uint_as_float(w & 0xffff0000u); }
__device__ __forceinline__ float silu(float x) { return x / (1.f + __expf(-x)); }

__device__ __forceinline__ void phase_prep(const Params& p, LAS unsigned char* lds) {
    int tid = threadIdx.x; asm volatile("" : "+v"(tid));
    const int lane = tid & 63, wid = tid >> 6;
    unsigned char* ws = p.ws;
    u64* sumsq = (u64*)(ws + WS_SUMSQ);
    for (int i = blockIdx.x * NTHREADS + tid; i < 4 * T; i += gridDim.x * NTHREADS) sumsq[T + i] = 0ull;
    u16* xb = (u16*)(ws + WS_XB);
    for (int row = blockIdx.x * 8 + wid; row < T; row += gridDim.x * 16) {
        const int row2 = row + gridDim.x * 8; const bool has2 = row2 < T;
        const float* xr = row < TP ? p.x_prompt + (size_t)row * 2048 : p.x_sample + (size_t)(row - TP) * 2048;
        const float* xr2 = has2 ? (row2 < TP ? p.x_prompt + (size_t)row2 * 2048 : p.x_sample + (size_t)(row2 - TP) * 2048) : xr;
        f32x4 va[8], vb[8];
#pragma unroll
        for (int j = 0; j < 8; ++j) { va[j] = *(const f32x4*)(xr + j * 256 + lane * 4); vb[j] = *(const f32x4*)(xr2 + j * 256 + lane * 4); }
        float ss = 0.f, ss2 = 0.f;
#pragma unroll
        for (int j = 0; j < 8; ++j) {
            ss += va[j][0] * va[j][0] + va[j][1] * va[j][1] + va[j][2] * va[j][2] + va[j][3] * va[j][3];
            ss2 += vb[j][0] * vb[j][0] + vb[j][1] * vb[j][1] + vb[j][2] * vb[j][2] + vb[j][3] * vb[j][3];
            u32x2 w; w.x = cvt_pk_bf16(va[j][0], va[j][1]); w.y = cvt_pk_bf16(va[j][2], va[j][3]);
            *(u32x2*)(xb + (size_t)row * 2048 + j * 256 + lane * 4) = w;
            if (has2) { u32x2 w2; w2.x = cvt_pk_bf16(vb[j][0], vb[j][1]); w2.y = cvt_pk_bf16(vb[j][2], vb[j][3]);
                *(u32x2*)(xb + (size_t)row2 * 2048 + j * 256 + lane * 4) = w2; }
        }
#pragma unroll
        for (int o = 32; o >= 1; o >>= 1) { ss += __shfl_xor(ss, o); ss2 += __shfl_xor(ss2, o); }
        if (lane == 0) { sumsq[row] = (u64)(ss * SS_SCALE); if (has2) sumsq[row2] = (u64)(ss2 * SS_SCALE); }
    }
    for (int e = blockIdx.x * NTHREADS + tid; e < DEPTH * 2048 * 16; e += gridDim.x * NTHREADS) {
        const int l = e / (2048 * 16), r = e % (2048 * 16), k = r >> 4, n = r & 15;
        const float v = p.w_in[((size_t)l * 2048 + k) * DIN + 3072 + n] * p.norm_g[l * 2048 + k];
        ((u16*)(ws + WS_WTIN))[((size_t)l * NZROWS + 6144 + n) * 2048 + k] = f2bf(v);
    }
    for (int e = blockIdx.x * NTHREADS + tid; e < DEPTH * 4 * 128 * 128; e += gridDim.x * NTHREADS) {
        const int t = (e >> 7) & 127, s = e & 127;
        ((u16*)(ws + WS_WSB))[e] = f2bf(s <= t ? p.w_s[e] : 0.f);
    }
    LAS float* tile = (LAS float*)lds;
#define PREP_DECODE(job, src, dst, ldsrc, k0, n0, srccol0, g) do { const int _l = (job) >> 10; int _r = (job) & 1023; int _kt, _nb; \
        if (_r < 768) { _kt = _r / 24; _nb = _r % 24; src = p.w_in + (size_t)_l * 2048 * DIN; ldsrc = DIN; srccol0 = _nb * 256 + (_nb >= 12 ? 16 : 0); \
            dst = (u16*)(ws + WS_WTIN) + (size_t)_l * NZROWS * 2048; g = p.norm_g + _l * 2048; } \
        else { _r -= 768; _kt = _r >> 3; _nb = _r & 7; src = p.w_out + (size_t)_l * 2048 * 2048; ldsrc = 2048; srccol0 = _nb * 256; \
            dst = (u16*)(ws + WS_WTOUT) + (size_t)_l * 2048 * 2048; g = nullptr; } \
        k0 = _kt * 64; n0 = _nb * 256; } while (0)
#define PREP_LOAD(job) do { const float* _src; u16* _dst; int _ld, _k0, _n0, _sc; const float* _g; PREP_DECODE(job, _src, _dst, _ld, _k0, _n0, _sc, _g); (void)_dst; (void)_n0; \
        _Pragma("unroll") for (int i = 0; i < 8; ++i) { const int e = tid + i * 512, rr = e >> 6, c4 = (e & 63) * 4; \
            v[i] = *(const f32x4*)(_src + (size_t)(_k0 + rr) * _ld + _sc + c4); gv[i] = _g ? _g[_k0 + rr] : 1.f; } } while (0)
    {
        f32x4 v[8]; float gv[8];
        int job = blockIdx.x;
        if (job < DEPTH * 1024) PREP_LOAD(job);
        for (; job < DEPTH * 1024; job += gridDim.x) {
            const float* src; u16* dst; int ldsrc, k0, n0, srccol0; const float* g;
            PREP_DECODE(job, src, dst, ldsrc, k0, n0, srccol0, g); (void)src; (void)ldsrc; (void)srccol0; (void)g;
#pragma unroll
            for (int i = 0; i < 8; ++i) { const int e = tid + i * 512, rr = e >> 6, c4 = (e & 63) * 4;
#pragma unroll
                for (int j = 0; j < 4; ++j) tile[rr * 257 + c4 + j] = v[i][j] * gv[i]; }
            const int nextjob = job + gridDim.x;
            if (nextjob < DEPTH * 1024) PREP_LOAD(nextjob);
            __syncthreads();
#pragma unroll
            for (int i = 0; i < 4; ++i) { const int e = tid + i * 512, n = e >> 3, ko = (e & 7) * 8;
                u32x4 wv;
                wv.x = cvt_pk_bf16(tile[(ko + 0) * 257 + n], tile[(ko + 1) * 257 + n]); wv.y = cvt_pk_bf16(tile[(ko + 2) * 257 + n], tile[(ko + 3) * 257 + n]);
                wv.z = cvt_pk_bf16(tile[(ko + 4) * 257 + n], tile[(ko + 5) * 257 + n]); wv.w = cvt_pk_bf16(tile[(ko + 6) * 257 + n], tile[(ko + 7) * 257 + n]);
                *(u32x4*)(dst + (size_t)(n0 + n) * 2048 + k0 + ko) = wv; }
            __syncthreads();
        }
    }
#undef PREP_DECODE
#undef PREP_LOAD
}

constexpr int BM = 256, BK = 64, HALF = 128, HTB = HALF * BK * 2, NXCD = 8, WGM = 8;
__device__ __forceinline__ int lds_byte(int r, int c) { const int st = (r >> 4) * 2 + (c >> 5), rr = r & 15, cc = c & 31, ob = rr * 64 + cc * 2; return st * 1024 + (ob ^ (((ob >> 9) & 1) << 5)); }
__device__ __forceinline__ void stage_rc(int b, int& R, int& C) { const int st = b / 1024, sb = b % 1024, swz = sb ^ (((sb >> 9) & 1) << 5); R = (st >> 1) * 16 + swz / 64; C = (st & 1) * 32 + (swz % 64) / 2; }
__device__ __forceinline__ int perm32(int rho) { const int n = rho >> 4, i = rho & 15; return 8 * (i >> 2) + 4 * n + (i & 3); }
struct Unit { int pm, pn; };
__device__ __forceinline__ bool unit_next(int i, int G, int c, int nM, int nN, Unit& u) {
    const int nwg = nM * nN; const long L = (long)i * G + c; if (L >= nwg) return false;
    int wgid = (int)L; { const int q = nwg / NXCD, r = nwg % NXCD, xcd = wgid % NXCD, off = wgid / NXCD; wgid = (xcd < r ? xcd * (q + 1) : r * (q + 1) + (xcd - r) * q) + off; }
    const int nig = WGM * nN, gid = wgid / nig, fm = gid * WGM, gsz = (nM - fm) < WGM ? (nM - fm) : WGM;
    u.pm = fm + ((wgid % nig) % gsz); u.pn = (wgid % nig) / gsz; return true;
}
template <int MODE> __device__ __forceinline__ bool unit_swapped(const Unit& u) { return MODE == 0 && ((u.pn >= 4 && u.pn < 8) || (u.pn >= 16 && u.pn < 20)); }
template <int MODE> __device__ __forceinline__ void unit_ptrs(const char* act, const char* wt, const Unit& u, const char*& a, const char*& b) {
    const size_t tstep = (size_t)256 * 2048 * 2;
    const char* pa = act + (size_t)u.pm * tstep; const char* pb = wt + (size_t)u.pn * tstep;
    const bool sw = unit_swapped<MODE>(u);
    a = sw ? pb : pa; b = sw ? pa : pb;
}

template <int MODE>
__device__ __forceinline__ void gemm_epilogue(const Params& p, int l, const f32x4 (&acc)[2][2][4][2], const Unit& u, int wr, int wc, int fr, int fq, const LAS float* rl, int pm0) {
    unsigned char* ws = p.ws;
    const __amdgpu_buffer_rsrc_t wsr = __builtin_amdgcn_make_buffer_rsrc((void*)ws, (short)0, (int)WS_END, 0x00020000);
#define WT_STORE16(ptr, val) __builtin_amdgcn_raw_buffer_store_b128((val), wsr, (int)((const char*)(ptr) - (const char*)ws), 0, 16)
    if (MODE == 0) {
        const u64* ss = (const u64*)(ws + WS_SUMSQ) + (size_t)l * T;
        if (!unit_swapped<0>(u)) {
            const int pn = u.pn;
            u16* ob; int ld;
            if (pn < 2) { ob = (u16*)(ws + WS_ZQ) + pn * 256; ld = 512; }
            else if (pn < 4) { ob = (u16*)(ws + WS_ZK) + (pn - 2) * 256; ld = 512; }
            else if (pn < 12) { ob = (u16*)(ws + WS_ZGA) + (pn - 8) * 256; ld = 1024; }
            else if (pn < 16) { ob = (u16*)(ws + WS_ZU) + (pn - 12) * 256; ld = 1024; }
            else { ob = (u16*)(ws + WS_ZGB) + (pn - 20) * 256; ld = 1024; }
#pragma unroll
            for (int ai = 0; ai < 2; ++ai)
#pragma unroll
                for (int m = 0; m < 4; ++m) {
                    const int tok = u.pm * 256 + 128 * ai + 64 * wr + 16 * m + fr;
                    const float rs = (u.pm == pm0) ? rl[128 * ai + 64 * wr + 16 * m + fr] : rstd_of(ss[tok]);
#pragma unroll
                    for (int bj = 0; bj < 2; ++bj) {
                        const f32x4 v0 = acc[ai][bj][m][0] * rs, v1 = acc[ai][bj][m][1] * rs;
                        u32x4 w; w.x = cvt_pk_bf16(v0[0], v0[1]); w.y = cvt_pk_bf16(v0[2], v0[3]); w.z = cvt_pk_bf16(v1[0], v1[1]); w.w = cvt_pk_bf16(v1[2], v1[3]);
                        WT_STORE16(ob + (size_t)tok * ld + 128 * bj + 32 * wc + 8 * fq, w);
                    }
                }
        } else {
            u16* ob = (u.pn < 8) ? (u16*)(ws + WS_ZVT) + (size_t)((u.pn - 4) * 256) * T : (u16*)(ws + WS_ZVMT) + (size_t)((u.pn - 16) * 256) * T;
#pragma unroll
            for (int bj = 0; bj < 2; ++bj) {
                const int tok0 = u.pm * 256 + 128 * bj + 32 * wc + 8 * fq;
                f32x4 s0, s1;
#pragma unroll
                for (int e = 0; e < 4; ++e) { s0[e] = (u.pm == pm0) ? rl[128 * bj + 32 * wc + 8 * fq + e] : rstd_of(ss[tok0 + e]); s1[e] = (u.pm == pm0) ? rl[128 * bj + 32 * wc + 8 * fq + 4 + e] : rstd_of(ss[tok0 + 4 + e]); }
#pragma unroll
                for (int ai = 0; ai < 2; ++ai)
#pragma unroll
                    for (int m = 0; m < 4; ++m) {
                        const int zr = 128 * ai + 64 * wr + 16 * m + fr;
                        const f32x4 v0 = acc[ai][bj][m][0] * s0, v1 = acc[ai][bj][m][1] * s1;
                        u32x4 w; w.x = cvt_pk_bf16(v0[0], v0[1]); w.y = cvt_pk_bf16(v0[2], v0[3]); w.z = cvt_pk_bf16(v1[0], v1[1]); w.w = cvt_pk_bf16(v1[2], v1[3]);
                        WT_STORE16(ob + (size_t)zr * T + tok0, w);
                    }
            }
        }
    } else {
        u16* xb = (u16*)(ws + WS_XB);
        u64* ssn = (u64*)(ws + WS_SUMSQ) + (size_t)(l + 1) * T;
#pragma unroll
        for (int ai = 0; ai < 2; ++ai)
#pragma unroll
            for (int m = 0; m < 4; ++m) {
                const int tok = u.pm * 256 + 128 * ai + 64 * wr + 16 * m + fr;
                float part = 0.f;
#pragma unroll
                for (int bj = 0; bj < 2; ++bj) {
                    const size_t idx = (size_t)tok * 2048 + u.pn * 256 + 128 * bj + 32 * wc + 8 * fq;
                    const u32x4 xw = *(const u32x4*)(xb + idx);
                    f32x4 y0 = (f32x4){bflo(xw.x), bfhi(xw.x), bflo(xw.y), bfhi(xw.y)}, y1 = (f32x4){bflo(xw.z), bfhi(xw.z), bflo(xw.w), bfhi(xw.w)};
                    y0 += acc[ai][bj][m][0]; y1 += acc[ai][bj][m][1];
                    part += y0[0] * y0[0] + y0[1] * y0[1] + y0[2] * y0[2] + y0[3] * y0[3] + y1[0] * y1[0] + y1[1] * y1[1] + y1[2] * y1[2] + y1[3] * y1[3];
                    u32x4 w; w.x = cvt_pk_bf16(y0[0], y0[1]); w.y = cvt_pk_bf16(y0[2], y0[3]); w.z = cvt_pk_bf16(y1[0], y1[1]); w.w = cvt_pk_bf16(y1[2], y1[3]);
                    WT_STORE16(xb + idx, w);
                }
                part += __shfl_xor(part, 16); part += __shfl_xor(part, 32);
                if (fq == 0) atomicAdd(ssn + tok, (u64)(part * SS_SCALE));
            }
    }
}

#undef WT_STORE16
template <int MODE>
__device__ __forceinline__ void gemm_phase(LAS unsigned char* lds, const Params& p, int l, int single) {
    int tid = threadIdx.x; asm volatile("" : "+v"(tid)); asm volatile("" : "+s"(l));
    const int wid = __builtin_amdgcn_readfirstlane(tid >> 6), lane = tid & 63, wr = wid >> 2, wc = wid & 3, fr = lane & 15, fq = lane >> 4;
    constexpr int K = 2048, nt = K / BK;
    const int nM = TP / 256, nN = (MODE == 0) ? 24 : 8, G = gridDim.x, cidx = blockIdx.x;
    const char* act = (MODE == 0) ? (const char*)(p.ws + WS_XB) : (const char*)(p.ws + WS_OBUF);
    const char* wt = (MODE == 0) ? (const char*)(p.ws + WS_WTIN) + (size_t)l * NZROWS * 2048 * 2 : (const char*)(p.ws + WS_WTOUT) + (size_t)l * 2048 * 2048 * 2;
    unsigned voffA[2], voffB[2];
#pragma unroll
    for (int i = 0; i < 2; ++i) { int R, C; stage_rc(tid * 16 + i * 8192, R, C); const int Rb = (R & ~31) + perm32(R & 31);
        voffA[i] = (unsigned)(R * K + C) * 2u; voffB[i] = (unsigned)(Rb * K + C) * 2u; }
    const size_t kstep = (size_t)(BK * 2);
    const size_t hstep = (size_t)HALF * K * 2;
    const unsigned ldsw = (unsigned)wid * 1024u;
    const int aoff = lds_byte(wr * 64 + fr, fq * 8), boff = lds_byte(wc * 32 + fr, fq * 8);
#define PG8_SA(b, h) (((b) * 2 + (h)) * HTB)
#define PG8_SB(b, h) ((4 + (b) * 2 + (h)) * HTB)
#define PG8_STAGE(bufoff, gbase, voff) do { _Pragma("unroll") for (int _i = 0; _i < 2; ++_i) \
        __builtin_amdgcn_global_load_lds((const unsigned*)((const char*)(gbase) + (voff)[_i]), (LAS unsigned*)(lds + (bufoff) + ldsw + _i * 8192), 16, 0, 0); } while (0)
#define PG8_LDA(dst, b, h) do { _Pragma("unroll") for (int m = 0; m < 4; ++m) _Pragma("unroll") for (int k = 0; k < 2; ++k) dst[m][k] = *(const LAS bf16x8*)(lds + PG8_SA(b, h) + aoff + m * 2048 + k * 1024); } while (0)
#define PG8_LDB(dst, b, h) do { _Pragma("unroll") for (int n = 0; n < 2; ++n) _Pragma("unroll") for (int k = 0; k < 2; ++k) dst[n][k] = *(const LAS bf16x8*)(lds + PG8_SB(b, h) + boff + n * 2048 + k * 1024); } while (0)
#define PG8_MMA(ai, bj, At, Bt) do { __builtin_amdgcn_s_setprio(1); _Pragma("unroll") for (int m = 0; m < 4; ++m) _Pragma("unroll") for (int n = 0; n < 2; ++n) _Pragma("unroll") for (int k = 0; k < 2; ++k) \
        acc[ai][bj][m][n] = __builtin_amdgcn_mfma_f32_16x16x32_bf16(Bt[n][k], At[m][k], acc[ai][bj][m][n], 0, 0, 0); __builtin_amdgcn_s_setprio(0); } while (0)
#define PG8_WAIT_V(n) asm volatile("s_waitcnt vmcnt(" #n ")" ::: "memory")
#define PG8_WAIT_L(n) asm volatile("s_waitcnt lgkmcnt(" #n ")" ::: "memory")
#define PG8_BAR __builtin_amdgcn_s_barrier()
#define PG8_SCHED __builtin_amdgcn_sched_barrier(0)
    Unit cur, nxt; int ui = 0;
    if (single >= 0) { cur.pm = nM + single / nN; cur.pn = single % nN; }
    else if (!unit_next(0, G, cidx, nM, nN, cur)) return;
    LAS float* rl = (LAS float*)(lds + 131072 + 256);
    const int pm0 = cur.pm;
    if (MODE == 0) {
        if (tid < 256) rl[tid] = rstd_of(((const u64*)(p.ws + WS_SUMSQ))[(size_t)l * T + pm0 * 256 + tid]);
        __syncthreads();
    }
    f32x4 acc[2][2][4][2];
#pragma unroll
    for (int a = 0; a < 2; ++a)
#pragma unroll
        for (int b = 0; b < 2; ++b)
#pragma unroll
            for (int m = 0; m < 4; ++m)
#pragma unroll
                for (int n = 0; n < 2; ++n) acc[a][b][m][n] = (f32x4){0.f, 0.f, 0.f, 0.f};
    bf16x8 At[4][2], B0[2][2], B1[2][2];
    const char *cA, *cB; unit_ptrs<MODE>(act, wt, cur, cA, cB);
    PG8_STAGE(PG8_SB(0, 0), cB, voffB); PG8_STAGE(PG8_SA(0, 0), cA, voffA); PG8_STAGE(PG8_SB(0, 1), cB + hstep, voffB); PG8_STAGE(PG8_SA(0, 1), cA + hstep, voffA);
    if (wr == 1) PG8_BAR;
    PG8_WAIT_V(4); PG8_BAR;
    PG8_STAGE(PG8_SB(1, 0), cB + kstep, voffB); PG8_STAGE(PG8_SA(1, 0), cA + kstep, voffA); PG8_STAGE(PG8_SB(1, 1), cB + hstep + kstep, voffB);
    PG8_WAIT_V(6); PG8_BAR;
    for (;;) {
        const bool has_next = (single < 0) && unit_next(ui + 1, G, cidx, nM, nN, nxt);
        const char *nA = cA, *nB = cB;
        if (has_next) unit_ptrs<MODE>(act, wt, nxt, nA, nB);
        for (int t = 0; t < nt; t += 2) {
            const bool last = (t == nt - 2);
            const char* a1 = cA + (size_t)(t + 1) * kstep;
            const char* a2 = last ? nA : cA + (size_t)(t + 2) * kstep; const char* b2 = last ? nB : cB + (size_t)(t + 2) * kstep;
            const char* a3 = a2 + kstep; const char* b3 = b2 + kstep;
            PG8_LDB(B0, 0, 0); PG8_SCHED; PG8_LDA(At, 0, 0); PG8_STAGE(PG8_SA(1, 1), a1 + hstep, voffA);
            PG8_WAIT_L(8); PG8_BAR; PG8_WAIT_L(0); PG8_MMA(0, 0, At, B0); PG8_BAR; PG8_SCHED;
            PG8_LDB(B1, 0, 1); PG8_STAGE(PG8_SB(0, 0), b2, voffB);
            PG8_BAR; PG8_WAIT_L(0); PG8_MMA(0, 1, At, B1); PG8_BAR;
            PG8_LDA(At, 0, 1); PG8_STAGE(PG8_SA(0, 0), a2, voffA);
            PG8_BAR; PG8_WAIT_L(0); PG8_MMA(1, 0, At, B0); PG8_BAR; PG8_SCHED;
            PG8_STAGE(PG8_SB(0, 1), b2 + hstep, voffB);
            PG8_WAIT_V(6); PG8_BAR; PG8_MMA(1, 1, At, B1); PG8_BAR;
            PG8_LDB(B0, 1, 0); PG8_SCHED; PG8_LDA(At, 1, 0); PG8_STAGE(PG8_SA(0, 1), a2 + hstep, voffA);
            PG8_WAIT_L(8); PG8_BAR; PG8_WAIT_L(0); PG8_MMA(0, 0, At, B0); PG8_BAR; PG8_SCHED;
            PG8_LDB(B1, 1, 1); PG8_STAGE(PG8_SB(1, 0), b3, voffB);
            PG8_BAR; PG8_WAIT_L(0); PG8_MMA(0, 1, At, B1); PG8_BAR;
            PG8_LDA(At, 1, 1); PG8_STAGE(PG8_SA(1, 0), a3, voffA);
            PG8_BAR; PG8_WAIT_L(0); PG8_MMA(1, 0, At, B0); PG8_BAR; PG8_SCHED;
            PG8_STAGE(PG8_SB(1, 1), b3 + hstep, voffB);
            PG8_WAIT_V(6); PG8_BAR; PG8_MMA(1, 1, At, B1); PG8_BAR;
        }
        gemm_epilogue<MODE>(p, l, acc, cur, wr, wc, fr, fq, rl, pm0);
        if (!has_next) break;
#pragma unroll
        for (int a = 0; a < 2; ++a)
#pragma unroll
            for (int b = 0; b < 2; ++b)
#pragma unroll
                for (int m = 0; m < 4; ++m)
#pragma unroll
                    for (int n = 0; n < 2; ++n) acc[a][b][m][n] = (f32x4){0.f, 0.f, 0.f, 0.f};
        cur = nxt; cA = nA; cB = nB; ++ui;
    }
    PG8_WAIT_V(0);
    if (wr == 0) PG8_BAR;
    PG8_BAR;
#undef PG8_SA
#undef PG8_SB
#undef PG8_STAGE
#undef PG8_LDA
#undef PG8_LDB
#undef PG8_MMA
#undef PG8_WAIT_V
#undef PG8_WAIT_L
#undef PG8_BAR
#undef PG8_SCHED
}

__device__ __forceinline__ void gla_gates(const Params& p, int l, int h, int tok0, int d, int tg, LAS float* gsum, float (&b)[16], float& blast) {
    LAS float* lrs = gsum + 25088;
    {
        const int t2 = threadIdx.x;
        if (t2 < 256) *(LAS f32x4*)(lrs + t2 * 4) = *(const f32x4*)((const float*)(p.ws + WS_ZLR) + (size_t)tok0 * 16 + t2 * 4);
    }
    const float* wg = p.w_gate_up + (size_t)l * 16 * 512 + h * 128 + d;
    float w[16];
#pragma unroll
    for (int r = 0; r < 16; ++r) w[r] = wg[r * 512];
    const float bg = p.b_gate[l * 512 + h * 128 + d];
    __syncthreads();
    const LAS float* lr = lrs + (tg * 16) * 16;
    float run = 0.f;
#pragma unroll
    for (int i = 0; i < 16; ++i) {
        float x = bg;
#pragma unroll
        for (int r4 = 0; r4 < 4; ++r4) { const f32x4 a = *(const LAS f32x4*)(lr + i * 16 + r4 * 4);
            x += a[0] * w[r4 * 4] + a[1] * w[r4 * 4 + 1] + a[2] * w[r4 * 4 + 2] + a[3] * w[r4 * 4 + 3]; }
        const float ls = fminf(x, 0.f) - __logf(1.f + __expf(-fabsf(x)));
        run += ls * (1.f / 16.f); b[i] = run;
    }
    gsum[tg * 128 + d] = run;
    __syncthreads();
    float off = 0.f, tot = 0.f;
#pragma unroll
    for (int g = 0; g < 4; ++g) { const float v = gsum[g * 128 + d]; tot += v; if (g < tg) off += v; }
#pragma unroll
    for (int i = 0; i < 16; ++i) b[i] += off;
    blast = tot;
}

__device__ __forceinline__ void gla_local_item(const Params& p, int l, int c, int h, LAS unsigned char* lds) {
    int tid = threadIdx.x; asm volatile("" : "+v"(tid)); asm volatile("" : "+s"(l));
    const int lane = tid & 63, w = tid >> 6, fr = lane & 15, fq = lane >> 4, d = tid & 127, tg = tid >> 7;
    unsigned char* ws = p.ws;
    LAS float* gsum = (LAS float*)lds;
    LAS float* decl = (LAS float*)(lds + 2048);
    LAS unsigned char* kT = lds + 4096;
    const int tok0 = c * 64;
    const u16* kp = (const u16*)(ws + WS_ZK) + (size_t)(tok0 + tg * 16) * 512 + h * 128 + d;
    u16 kraw[16];
#pragma unroll
    for (int i = 0; i < 16; ++i) kraw[i] = kp[i * 512];
    const u16* vt = (const u16*)(ws + WS_ZVT) + (size_t)(h * 256 + w * 32 + fr) * T + tok0 + fq * 8;
    bf16x8 bv[2][2];
#pragma unroll
    for (int kk = 0; kk < 2; ++kk)
#pragma unroll
        for (int n = 0; n < 2; ++n) bv[kk][n] = *(const bf16x8*)(vt + (size_t)(n * 16) * T + kk * 32);
    float b[16], blast;
    gla_gates(p, l, h, tok0, d, tg, gsum, b, blast);
    {
        unsigned* bc = (unsigned*)((u16*)(ws + WS_BCUM) + (size_t)(tok0 + tg * 16) * 512 + h * 128 + (d & ~1));
#pragma unroll
        for (int i = 0; i < 16; ++i) {
            const float ev = __expf(b[i]);
            const float eo = __shfl_down(ev, 1);
            if ((d & 1) == 0) bc[i * 256] = cvt_pk_bf16(ev, eo);
        }
        unsigned pk[8];
#pragma unroll
        for (int i = 0; i < 8; ++i) {
            const float k0 = bf2f(kraw[2 * i]) * __expf(blast - b[2 * i]);
            const float k1 = bf2f(kraw[2 * i + 1]) * __expf(blast - b[2 * i + 1]);
            pk[i] = cvt_pk_bf16(k0, k1);
        }
        u32x4 w0, w1; w0.x = pk[0]; w0.y = pk[1]; w0.z = pk[2]; w0.w = pk[3]; w1.x = pk[4]; w1.y = pk[5]; w1.z = pk[6]; w1.w = pk[7];
        *(LAS u32x4*)(kT + d * 144 + tg * 32) = w0; *(LAS u32x4*)(kT + d * 144 + tg * 32 + 16) = w1;
        if (tg == 0) { const float dc = __expf(blast); decl[d] = dc; ((float*)(ws + WS_DEC))[(size_t)(c * 4 + h) * 128 + d] = dc; }
    }
    __syncthreads();
    f32x4 acc[8][2];
#pragma unroll
    for (int mt = 0; mt < 8; ++mt) { acc[mt][0] = (f32x4){0.f, 0.f, 0.f, 0.f}; acc[mt][1] = (f32x4){0.f, 0.f, 0.f, 0.f}; }
#pragma unroll
    for (int kk = 0; kk < 2; ++kk) {
#pragma unroll
        for (int mt = 0; mt < 8; ++mt) {
            const bf16x8 a = *(const LAS bf16x8*)(kT + (mt * 16 + fr) * 144 + (kk * 32 + fq * 8) * 2);
#pragma unroll
            for (int n = 0; n < 2; ++n) acc[mt][n] = __builtin_amdgcn_mfma_f32_16x16x32_bf16(a, bv[kk][n], acc[mt][n], 0, 0, 0);
        }
    }
    if (c < 256) {
        u16* ut = (u16*)(ws + WS_UT) + (size_t)(c * 4 + h) * 32768;
#pragma unroll
        for (int mt = 0; mt < 8; ++mt)
#pragma unroll
            for (int n = 0; n < 2; ++n) {
                u32x2 wv; wv.x = cvt_pk_bf16(acc[mt][n][0], acc[mt][n][1]); wv.y = cvt_pk_bf16(acc[mt][n][2], acc[mt][n][3]);
                *(u32x2*)(ut + (w * 32 + n * 16 + fr) * 128 + mt * 16 + fq * 4) = wv;
            }
    } else {
        const int s = c - 256;
        const size_t sidx = (((size_t)l * 8 + s) * 4 + h) * 32768;
        const float* s0 = p.state_gla + sidx;
        float* so = p.out + OFF_GSS + sidx;
        u16* sp = (u16*)(ws + WS_SP) + (size_t)(c * 4 + h) * 32768;
#pragma unroll
        for (int mt = 0; mt < 8; ++mt)
#pragma unroll
            for (int n = 0; n < 2; ++n) {
                const int dv = w * 32 + n * 16 + fr, dk0 = mt * 16 + fq * 4;
                float sv[4];
#pragma unroll
                for (int e = 0; e < 4; ++e) { sv[e] = s0[(dk0 + e) * 256 + dv]; so[(dk0 + e) * 256 + dv] = decl[dk0 + e] * sv[e] + acc[mt][n][e]; }
                u32x2 wv; wv.x = cvt_pk_bf16(sv[0], sv[1]); wv.y = cvt_pk_bf16(sv[2], sv[3]);
                *(u32x2*)(sp + dv * 128 + dk0) = wv;
            }
    }
    __syncthreads();
}

__device__ __forceinline__ void scan_task(const Params& p, int l, int j, LAS unsigned char* lds) {
    unsigned char* ws = p.ws;
    int tid = threadIdx.x; asm volatile("" : "+v"(tid)); asm volatile("" : "+s"(l));
    const int e = j * 2048 + tid * 4;
    const int h = e >> 15, dk = e & 127, dv = (e >> 7) & 255;
    const u16* ut = (const u16*)(ws + WS_UT) + e; u16* sp = (u16*)(ws + WS_SP) + e;
    LAS float* dl = (LAS float*)lds;
    {
        const float* dsrc = (const float*)(ws + WS_DEC) + h * 128;
#pragma unroll
        for (int i = 0; i < 16; ++i) { const int q = tid + i * 512, c = q >> 5, d4 = (q & 31) * 4; *(LAS f32x4*)(dl + c * 128 + d4) = *(const f32x4*)(dsrc + (size_t)c * 512 + d4); }
    }
    f32x4 S = (f32x4){0.f, 0.f, 0.f, 0.f};
    u32x2 uvA[16], uvB[16];
#define SCAN_LOAD(uv, cb) do { _Pragma("unroll") for (int i = 0; i < 16; ++i) uv[i] = *(const u32x2*)(ut + (size_t)((cb) + i) * 131072); } while (0)
#define SCAN_STEP(uv, cb) do { _Pragma("unroll") for (int i = 0; i < 16; ++i) { \
            const f32x4 dd = *(const LAS f32x4*)(dl + ((cb) + i) * 128 + dk); \
            u32x2 wv; wv.x = cvt_pk_bf16(S[0], S[1]); wv.y = cvt_pk_bf16(S[2], S[3]); \
            *(u32x2*)(sp + (size_t)((cb) + i) * 131072) = wv; \
            S[0] = dd[0] * S[0] + bflo(uv[i].x); S[1] = dd[1] * S[1] + bfhi(uv[i].x); \
            S[2] = dd[2] * S[2] + bflo(uv[i].y); S[3] = dd[3] * S[3] + bfhi(uv[i].y); } } while (0)
    SCAN_LOAD(uvA, 0);
    __syncthreads();
    for (int c0 = 0; c0 < 256; c0 += 32) {
        SCAN_LOAD(uvB, c0 + 16);
        SCAN_STEP(uvA, c0);
        if (c0 + 32 < 256) SCAN_LOAD(uvA, c0 + 32);
        SCAN_STEP(uvB, c0 + 16);
    }
#undef SCAN_LOAD
#undef SCAN_STEP
    float* go = p.out + OFF_GSP + ((size_t)l * 4 + h) * 32768 + dk * 256 + dv;
#pragma unroll
    for (int i = 0; i < 4; ++i) go[i * 256] = S[i];
}

template <bool SMP>
__device__ __forceinline__ void gla_out_item(const Params& p, int l, int c, int h, LAS unsigned char* lds) {
    int tid = threadIdx.x; asm volatile("" : "+v"(tid)); asm volatile("" : "+s"(l));
    const int lane = tid & 63, w = tid >> 6, fr = lane & 15, fq = lane >> 4, d = tid & 127, tg = tid >> 7;
    unsigned char* ws = p.ws;
    LAS float* red = (LAS float*)(lds + 2048);
    LAS unsigned char* Q = lds + 4096;
    LAS unsigned char* Kt = Q + 17408;
    LAS unsigned char* P = Kt + 17408;
    const int tok0 = c * 64;
    const size_t rowoff = (size_t)(tok0 + tg * 16) * 512 + h * 128 + d;
    const float* bc = (const float*)(ws + WS_BCUM) + rowoff;
    const u16* qp = (const u16*)(ws + WS_ZQ) + rowoff;
    const u16* kp = (const u16*)(ws + WS_ZK) + rowoff;
    float b[16]; u16 qraw[16], kraw[16];
    const int t8 = tid >> 3, dg = (tid & 7) * 16;
    u32x4 qw0, qw1, kw0, kw1, ew0, ew1;
    if (!SMP) {
        const size_t ro = (size_t)(tok0 + t8) * 512 + h * 128 + dg;
        qw0 = *(const u32x4*)((const u16*)(ws + WS_ZQ) + ro); qw1 = *(const u32x4*)((const u16*)(ws + WS_ZQ) + ro + 8);
        kw0 = *(const u32x4*)((const u16*)(ws + WS_ZK) + ro); kw1 = *(const u32x4*)((const u16*)(ws + WS_ZK) + ro + 8);
        ew0 = *(const u32x4*)((const u16*)(ws + WS_BCUM) + ro); ew1 = *(const u32x4*)((const u16*)(ws + WS_BCUM) + ro + 8);
    } else {
#pragma unroll
        for (int i = 0; i < 16; ++i) { qraw[i] = qp[i * 512]; kraw[i] = kp[i * 512]; }
    }
    const u16* vt = (const u16*)(ws + WS_ZVT) + (size_t)(h * 256 + w * 32 + fr) * T + tok0 + fq * 8;
    bf16x8 bv[2][2];
#pragma unroll
    for (int kk = 0; kk < 2; ++kk)
#pragma unroll
        for (int n = 0; n < 2; ++n) bv[kk][n] = *(const bf16x8*)(vt + (size_t)(n * 16) * T + kk * 32);
    const u16* sp = (const u16*)(ws + WS_SP) + (size_t)(c * 4 + h) * 32768 + (size_t)(w * 32 + fr) * 128 + fq * 8;
    bf16x8 bs[4][2];
    if (!SMP) {
#pragma unroll
        for (int kk = 0; kk < 4; ++kk)
#pragma unroll
            for (int n = 0; n < 2; ++n) bs[kk][n] = *(const bf16x8*)(sp + n * 16 * 128 + kk * 32);
    } else {
        const float* s0 = p.state_gla + (((size_t)l * 8 + (c - 256)) * 4 + h) * 32768 + w * 32 + fr;
#pragma unroll
        for (int kk = 0; kk < 4; ++kk)
#pragma unroll
            for (int n = 0; n < 2; ++n) {
                float sv[8];
#pragma unroll
                for (int j = 0; j < 8; ++j) sv[j] = s0[(size_t)(kk * 32 + fq * 8 + j) * 256 + n * 16];
                u32x4 pw; pw.x = cvt_pk_bf16(sv[0], sv[1]); pw.y = cvt_pk_bf16(sv[2], sv[3]); pw.z = cvt_pk_bf16(sv[4], sv[5]); pw.w = cvt_pk_bf16(sv[6], sv[7]);
                bs[kk][n] = __builtin_bit_cast(bf16x8, pw);
            }
    }
    u32x2 gav[4][2];
#pragma unroll
    for (int mt = 0; mt < 4; ++mt)
#pragma unroll
        for (int n = 0; n < 2; ++n) gav[mt][n] = *(const u32x2*)((const u16*)(ws + WS_ZGA) + (size_t)(tok0 + mt * 16 + fr) * 1024 + h * 256 + w * 32 + n * 16 + fq * 4);
    if (SMP) {
        float blast; gla_gates(p, l, h, tok0, d, tg, (LAS float*)lds, b, blast);
#pragma unroll
        for (int i = 0; i < 16; ++i) {
            const int t = tg * 16 + i;
            const float qv = bf2f(qraw[i]) * 0.08838834764831845f * __expf(b[i]);
            const float kv = bf2f(kraw[i]) * __expf(-b[i]);
            ((LAS u16*)Q)[t * 136 + d] = f2bf(qv); ((LAS u16*)Kt)[t * 136 + d] = f2bf(kv);
        }
    } else {
        const unsigned qq[8] = {qw0.x, qw0.y, qw0.z, qw0.w, qw1.x, qw1.y, qw1.z, qw1.w};
        const unsigned kk8[8] = {kw0.x, kw0.y, kw0.z, kw0.w, kw1.x, kw1.y, kw1.z, kw1.w};
        const unsigned ee[8] = {ew0.x, ew0.y, ew0.z, ew0.w, ew1.x, ew1.y, ew1.z, ew1.w};
        unsigned qo[8], ko[8];
#pragma unroll
        for (int j = 0; j < 8; ++j) {
            const float e0 = bflo(ee[j]), e1 = bfhi(ee[j]);
            const float q0 = bflo(qq[j]) * 0.08838834764831845f * e0, q1 = bfhi(qq[j]) * 0.08838834764831845f * e1;
            const float k0 = bflo(kk8[j]) * __builtin_amdgcn_rcpf(e0), k1 = bfhi(kk8[j]) * __builtin_amdgcn_rcpf(e1);
            qo[j] = cvt_pk_bf16(q0, q1); ko[j] = cvt_pk_bf16(k0, k1);
        }
        u32x4 w0, w1; w0.x = qo[0]; w0.y = qo[1]; w0.z = qo[2]; w0.w = qo[3]; w1.x = qo[4]; w1.y = qo[5]; w1.z = qo[6]; w1.w = qo[7];
        *(LAS u32x4*)(Q + t8 * 272 + dg * 2) = w0; *(LAS u32x4*)(Q + t8 * 272 + dg * 2 + 16) = w1;
        w0.x = ko[0]; w0.y = ko[1]; w0.z = ko[2]; w0.w = ko[3]; w1.x = ko[4]; w1.y = ko[5]; w1.z = ko[6]; w1.w = ko[7];
        *(LAS u32x4*)(Kt + t8 * 272 + dg * 2) = w0; *(LAS u32x4*)(Kt + t8 * 272 + dg * 2 + 16) = w1;
    }
    __syncthreads();
    {
        const int mt = w >> 1;
#pragma unroll
        for (int j = 0; j < 2; ++j) {
            const int nt = (w & 1) * 2 + j;
            f32x4 s = (f32x4){0.f, 0.f, 0.f, 0.f};
            if (nt <= mt) {
#pragma unroll
                for (int kk = 0; kk < 4; ++kk) {
                    const bf16x8 a = *(const LAS bf16x8*)(Q + (mt * 16 + fr) * 272 + (kk * 32 + fq * 8) * 2);
                    const bf16x8 bq = *(const LAS bf16x8*)(Kt + (nt * 16 + fr) * 272 + (kk * 32 + fq * 8) * 2);
                    s = __builtin_amdgcn_mfma_f32_16x16x32_bf16(a, bq, s, 0, 0, 0);
                }
            }
#pragma unroll
            for (int e = 0; e < 4; ++e) { const int t = mt * 16 + fq * 4 + e, si = nt * 16 + fr; ((LAS u16*)P)[t * 72 + si] = f2bf(si <= t ? s[e] : 0.f); }
        }
    }
    __syncthreads();
    f32x4 o[4][2];
#pragma unroll
    for (int mt = 0; mt < 4; ++mt) { o[mt][0] = (f32x4){0.f, 0.f, 0.f, 0.f}; o[mt][1] = (f32x4){0.f, 0.f, 0.f, 0.f}; }
#pragma unroll
    for (int kk = 0; kk < 2; ++kk) {
#pragma unroll
        for (int mt = 0; mt < 4; ++mt) {
            if (2 * kk <= mt) {
                const bf16x8 a = *(const LAS bf16x8*)(P + (mt * 16 + fr) * 144 + (kk * 32 + fq * 8) * 2);
#pragma unroll
                for (int n = 0; n < 2; ++n) o[mt][n] = __builtin_amdgcn_mfma_f32_16x16x32_bf16(bv[kk][n], a, o[mt][n], 0, 0, 0);
            }
        }
    }
#pragma unroll
    for (int kk = 0; kk < 4; ++kk) {
#pragma unroll
        for (int mt = 0; mt < 4; ++mt) {
            const bf16x8 a = *(const LAS bf16x8*)(Q + (mt * 16 + fr) * 272 + (kk * 32 + fq * 8) * 2);
#pragma unroll
            for (int n = 0; n < 2; ++n) o[mt][n] = __builtin_amdgcn_mfma_f32_16x16x32_bf16(bs[kk][n], a, o[mt][n], 0, 0, 0);
        }
    }
#pragma unroll
    for (int mt = 0; mt < 4; ++mt) {
        float s2 = 0.f;
#pragma unroll
        for (int n = 0; n < 2; ++n)
#pragma unroll
            for (int e = 0; e < 4; ++e) s2 += o[mt][n][e] * o[mt][n][e];
        s2 += __shfl_xor(s2, 16); s2 += __shfl_xor(s2, 32);
        if (fq == 0) red[w * 64 + mt * 16 + fr] = s2;
    }
    __syncthreads();
    const float* gn = p.gla_norm_g + l * 256 + w * 32 + fq * 4;
    const f32x4 g0 = *(const f32x4*)gn, g1 = *(const f32x4*)(gn + 16);
#pragma unroll
    for (int mt = 0; mt < 4; ++mt) {
        const int t = mt * 16 + fr;
        float tot = 0.f;
#pragma unroll
        for (int ww = 0; ww < 8; ++ww) tot += red[ww * 64 + t];
        const float rs = rsqrtf(tot * (1.f / 256.f) + EPS);
#pragma unroll
        for (int n = 0; n < 2; ++n) {
            const f32x4 gg = n ? g1 : g0; const u32x2 ga = gav[mt][n];
            const float o0 = o[mt][n][0] * rs * gg[0] * silu(bflo(ga.x)), o1 = o[mt][n][1] * rs * gg[1] * silu(bfhi(ga.x));
            const float o2 = o[mt][n][2] * rs * gg[2] * silu(bflo(ga.y)), o3 = o[mt][n][3] * rs * gg[3] * silu(bfhi(ga.y));
            u32x2 wv; wv.x = cvt_pk_bf16(o0, o1); wv.y = cvt_pk_bf16(o2, o3);
            *(u32x2*)((u16*)(ws + WS_OBUF) + (size_t)(tok0 + t) * 2048 + h * 256 + w * 32 + n * 16 + fq * 4) = wv;
        }
    }
    __syncthreads();
}

__device__ __forceinline__ void lr_item(const Params& p, int l, int c, LAS unsigned char* lds) {
    int tid = threadIdx.x; asm volatile("" : "+v"(tid)); asm volatile("" : "+s"(l));
    const int lane = tid & 63, w = tid >> 6, fr = lane & 15, fq = lane >> 4;
    unsigned char* ws = p.ws;
    const u16* xb = (const u16*)(ws + WS_XB) + (size_t)(c * 64) * 2048 + w * 256 + fq * 8;
    const u16* wl = (const u16*)(ws + WS_WTIN) + ((size_t)l * NZROWS + 6144 + fr) * 2048 + w * 256 + fq * 8;
    f32x4 acc[4];
#pragma unroll
    for (int mt = 0; mt < 4; ++mt) acc[mt] = (f32x4){0.f, 0.f, 0.f, 0.f};
#pragma unroll
    for (int kk = 0; kk < 8; ++kk) {
        const bf16x8 bw = *(const bf16x8*)(wl + kk * 32);
#pragma unroll
        for (int mt = 0; mt < 4; ++mt) {
            const bf16x8 a = *(const bf16x8*)(xb + (size_t)(mt * 16 + fr) * 2048 + kk * 32);
            acc[mt] = __builtin_amdgcn_mfma_f32_16x16x32_bf16(a, bw, acc[mt], 0, 0, 0);
        }
    }
    LAS float* red = (LAS float*)lds;
#pragma unroll
    for (int mt = 0; mt < 4; ++mt)
#pragma unroll
        for (int e = 0; e < 4; ++e) red[w * 1024 + (mt * 16 + fq * 4 + e) * 16 + fr] = acc[mt][e];
    __syncthreads();
    {
        const int o = tid * 2, t = o >> 4;
        float s0 = 0.f, s1 = 0.f;
#pragma unroll
        for (int ww = 0; ww < 8; ++ww) { s0 += red[ww * 1024 + o]; s1 += red[ww * 1024 + o + 1]; }
        const float rs = rstd_of(((const u64*)(ws + WS_SUMSQ))[(size_t)l * T + c * 64 + t]);
        float* zl = (float*)(ws + WS_ZLR) + (size_t)(c * 64) * 16 + o;
        zl[0] = s0 * rs; zl[1] = s1 * rs;
    }
    __syncthreads();
}

__device__ __forceinline__ void gla_sample_state_item(const Params& p, int l, int sidx4, LAS unsigned char* lds) {
    int tid = threadIdx.x; asm volatile("" : "+v"(tid)); asm volatile("" : "+s"(l));
    const int lane = tid & 63, wv = tid >> 6, fr = lane & 15, fq = lane >> 4, d = tid & 127, tg = tid >> 7;
    const int s = sidx4 >> 2, h = sidx4 & 3, tok0 = TP + s * 64;
    unsigned char* ws = p.ws;
    LAS float* gs = (LAS float*)(lds + 8192);
    LAS float* dl = (LAS float*)(lds + 8192 + 2048);
    LAS unsigned char* kt = lds + 16384;
    const u16* kp = (const u16*)(ws + WS_ZK) + (size_t)(tok0 + tg * 16) * 512 + h * 128 + d;
    u16 kr[16];
#pragma unroll
    for (int i = 0; i < 16; ++i) kr[i] = kp[i * 512];
    float b[16], blast;
    gla_gates(p, l, h, tok0, d, tg, gs, b, blast);
#pragma unroll
    for (int i = 0; i < 16; ++i) ((LAS u16*)kt)[d * 72 + tg * 16 + i] = f2bf(bf2f(kr[i]) * __expf(blast - b[i]));
    if (tg == 0) dl[d] = __expf(blast);
    __syncthreads();
    const u16* vt = (const u16*)(ws + WS_ZVT) + (size_t)(h * 256 + wv * 32 + fr) * T + tok0 + fq * 8;
    const size_t so_off = (((size_t)l * 8 + s) * 4 + h) * 32768;
    const float* s0 = p.state_gla + so_off;
    float* so = p.out + OFF_GSS + so_off;
#pragma unroll
    for (int n = 0; n < 2; ++n) {
        const bf16x8 v0 = *(const bf16x8*)(vt + (size_t)(n * 16) * T), v1 = *(const bf16x8*)(vt + (size_t)(n * 16) * T + 32);
        const int dv = wv * 32 + n * 16 + fr;
#pragma unroll
        for (int mt = 0; mt < 8; ++mt) {
            f32x4 a = (f32x4){0.f, 0.f, 0.f, 0.f};
            const bf16x8 k0 = *(const LAS bf16x8*)(kt + (mt * 16 + fr) * 144 + (fq * 8) * 2), k1 = *(const LAS bf16x8*)(kt + (mt * 16 + fr) * 144 + (32 + fq * 8) * 2);
            a = __builtin_amdgcn_mfma_f32_16x16x32_bf16(k0, v0, a, 0, 0, 0);
            a = __builtin_amdgcn_mfma_f32_16x16x32_bf16(k1, v1, a, 0, 0, 0);
            const int dk0 = mt * 16 + fq * 4;
#pragma unroll
            for (int e = 0; e < 4; ++e) so[(dk0 + e) * 256 + dv] = dl[dk0 + e] * s0[(dk0 + e) * 256 + dv] + a[e];
        }
    }
    __syncthreads();
}

__device__ __forceinline__ void gmlp_item(const Params& p, int l, int mc, int g, LAS unsigned char* lds) {
    int tid = threadIdx.x; asm volatile("" : "+v"(tid)); asm volatile("" : "+s"(l));
    const int lane = tid & 63, w = tid >> 6, fr = lane & 15, fq = lane >> 4;
    unsigned char* ws = p.ws;
    LAS float* rsum = (LAS float*)lds;
    LAS float* rsq = (LAS float*)(lds + 2048);
    LAS unsigned char* Vn = lds + 4096;
    LAS float* lnp = (LAS float*)(lds + 4096 + 69632);
    lnp[tid] = (tid < 256) ? p.mlp_ln_g[l * 1024 + g * 256 + tid] : p.mlp_ln_b[l * 1024 + g * 256 + tid - 256];
    const bool smp = mc >= 128;
    const int ntok = smp ? 64 : 128, tok0 = smp ? TP + (mc - 128) * 64 : mc * 128;
    const int tk = tid & 127, cq = tid >> 7; const bool active = tk < ntok;
    const int oct = tid & 15, row0 = tid >> 4; const bool act8 = oct * 8 < ntok;
    LAS float* part = (LAS float*)(lds + 77824);
    LAS float* stat = (LAS float*)(lds + 77824 + 8192);
    LAS unsigned char* Wl = lds + 88064;
    {
        const u16* wsrc = (const u16*)(ws + WS_WSB) + (size_t)(l * 4 + g) * 128 * 128;
        u32x4 wt[4];
#pragma unroll
        for (int i = 0; i < 4; ++i) { const int ch = tid + i * 512; wt[i] = *(const u32x4*)(wsrc + (ch >> 4) * 128 + (ch & 15) * 8); }
#pragma unroll
        for (int i = 0; i < 4; ++i) { const int ch = tid + i * 512; *(LAS u32x4*)(Wl + (ch >> 4) * 272 + (ch & 15) * 16) = wt[i]; }
    }
    u32x4 raw[8];
    {
        const u16* vp = (const u16*)(ws + WS_ZVMT) + (size_t)(g * 256 + row0) * T + tok0 + oct * 8;
#pragma unroll
        for (int i = 0; i < 8; ++i) raw[i] = act8 ? *(const u32x4*)(vp + (size_t)(32 * i) * T) : (u32x4){0u, 0u, 0u, 0u};
    }
    {
        float ps[8], pq[8];
#pragma unroll
        for (int j = 0; j < 8; ++j) { ps[j] = 0.f; pq[j] = 0.f; }
#pragma unroll
        for (int i = 0; i < 8; ++i) {
            const float x0 = bflo(raw[i].x), x1 = bfhi(raw[i].x), x2 = bflo(raw[i].y), x3 = bfhi(raw[i].y), x4 = bflo(raw[i].z), x5 = bfhi(raw[i].z), x6 = bflo(raw[i].w), x7 = bfhi(raw[i].w);
            ps[0] += x0; pq[0] += x0 * x0; ps[1] += x1; pq[1] += x1 * x1; ps[2] += x2; pq[2] += x2 * x2; ps[3] += x3; pq[3] += x3 * x3;
            ps[4] += x4; pq[4] += x4 * x4; ps[5] += x5; pq[5] += x5 * x5; ps[6] += x6; pq[6] += x6 * x6; ps[7] += x7; pq[7] += x7 * x7;
        }
#pragma unroll
        for (int j = 0; j < 8; ++j) { ps[j] += __shfl_xor(ps[j], 16); ps[j] += __shfl_xor(ps[j], 32); pq[j] += __shfl_xor(pq[j], 16); pq[j] += __shfl_xor(pq[j], 32); }
        if (lane < 16) {
#pragma unroll
            for (int j = 0; j < 8; ++j) { part[(w * 128 + oct * 8 + j) * 2] = ps[j]; part[(w * 128 + oct * 8 + j) * 2 + 1] = pq[j]; }
        }
    }
    __syncthreads();
    if (tid < 128) {
        float S = 0.f, S2 = 0.f;
#pragma unroll
        for (int ww = 0; ww < 8; ++ww) { S += part[(ww * 128 + tid) * 2]; S2 += part[(ww * 128 + tid) * 2 + 1]; }
        const float mu = S * (1.f / 256.f), var = fmaxf(S2 * (1.f / 256.f) - mu * mu, 0.f);
        stat[tid * 2] = mu; stat[tid * 2 + 1] = rsqrtf(var + EPS);
    }
    __syncthreads();
    {
        float mu[8], rs[8];
#pragma unroll
        for (int j = 0; j < 8; ++j) { mu[j] = stat[(oct * 8 + j) * 2]; rs[j] = stat[(oct * 8 + j) * 2 + 1]; }
        float* mvs = p.out + OFF_MVS + (((size_t)l * 8 + (mc - 128)) * 64 + oct * 8) * 1024 + g * 256;
#pragma unroll
        for (int i = 0; i < 8; ++i) {
            const int c = row0 + 32 * i; const float gg = lnp[c], bb = lnp[256 + c];
            float vn[8];
            vn[0] = (bflo(raw[i].x) - mu[0]) * rs[0] * gg + bb; vn[1] = (bfhi(raw[i].x) - mu[1]) * rs[1] * gg + bb;
            vn[2] = (bflo(raw[i].y) - mu[2]) * rs[2] * gg + bb; vn[3] = (bfhi(raw[i].y) - mu[3]) * rs[3] * gg + bb;
            vn[4] = (bflo(raw[i].z) - mu[4]) * rs[4] * gg + bb; vn[5] = (bfhi(raw[i].z) - mu[5]) * rs[5] * gg + bb;
            vn[6] = (bflo(raw[i].w) - mu[6]) * rs[6] * gg + bb; vn[7] = (bfhi(raw[i].w) - mu[7]) * rs[7] * gg + bb;
            u32x4 wv = (u32x4){0u, 0u, 0u, 0u};
            if (act8) {
                wv.x = cvt_pk_bf16(vn[0], vn[1]); wv.y = cvt_pk_bf16(vn[2], vn[3]); wv.z = cvt_pk_bf16(vn[4], vn[5]); wv.w = cvt_pk_bf16(vn[6], vn[7]);
                if (smp) {
#pragma unroll
                    for (int j = 0; j < 8; ++j) mvs[(size_t)j * 1024 + c] = vn[j];
                }
            }
            *(LAS u32x4*)(Vn + c * 272 + oct * 16) = wv;
        }
    }
    __syncthreads();
    const int ntt = ntok >> 4;
    f32x4 acc[2][8];
#pragma unroll
    for (int tt = 0; tt < 8; ++tt) { acc[0][tt] = (f32x4){0.f, 0.f, 0.f, 0.f}; acc[1][tt] = (f32x4){0.f, 0.f, 0.f, 0.f}; }
#pragma unroll
    for (int kk = 0; kk < 4; ++kk) {
        bf16x8 a[2];
#pragma unroll
        for (int ct = 0; ct < 2; ++ct) a[ct] = *(const LAS bf16x8*)(Vn + (w * 32 + ct * 16 + fr) * 272 + (kk * 32 + fq * 8) * 2);
#pragma unroll
        for (int tt = 0; tt < 8; ++tt) {
            if ((tt >> 1) >= kk && tt < ntt) {
                const bf16x8 bw = *(const LAS bf16x8*)(Wl + (tt * 16 + fr) * 272 + (kk * 32 + fq * 8) * 2);
#pragma unroll
                for (int ct = 0; ct < 2; ++ct) acc[ct][tt] = __builtin_amdgcn_mfma_f32_16x16x32_bf16(a[ct], bw, acc[ct][tt], 0, 0, 0);
            }
        }
    }
    const float* bsp = p.b_s + (size_t)(l * 4 + g) * 128;
#pragma unroll
    for (int tt = 0; tt < 8; ++tt) {
        if (tt < ntt) {
            const int tok = tok0 + tt * 16 + fr; const float bs = bsp[tt * 16 + fr];
#pragma unroll
            for (int ct = 0; ct < 2; ++ct) {
                const int cb = g * 256 + w * 32 + ct * 16 + fq * 4;
                const u32x2 uu = *(const u32x2*)((const u16*)(ws + WS_ZU) + (size_t)tok * 1024 + cb);
                const u32x2 gg = *(const u32x2*)((const u16*)(ws + WS_ZGB) + (size_t)tok * 1024 + cb);
                const float o0 = bflo(uu.x) * (acc[ct][tt][0] + bs) * silu(bflo(gg.x));
                const float o1 = bfhi(uu.x) * (acc[ct][tt][1] + bs) * silu(bfhi(gg.x));
                const float o2 = bflo(uu.y) * (acc[ct][tt][2] + bs) * silu(bflo(gg.y));
                const float o3 = bfhi(uu.y) * (acc[ct][tt][3] + bs) * silu(bfhi(gg.y));
                u32x2 wv; wv.x = cvt_pk_bf16(o0, o1); wv.y = cvt_pk_bf16(o2, o3);
                *(u32x2*)((u16*)(ws + WS_OBUF) + (size_t)tok * 2048 + 1024 + cb) = wv;
            }
        }
    }
    __syncthreads();
}

__device__ __forceinline__ void phase_final(const Params& p) {
    int tid = threadIdx.x; asm volatile("" : "+v"(tid));
    const int lane = tid & 63, wid = tid >> 6;
    const u16* xb = (const u16*)(p.ws + WS_XB);
    const u64* ss = (const u64*)(p.ws + WS_SUMSQ) + (size_t)4 * T;
    for (int row = blockIdx.x * 8 + wid; row < T; row += gridDim.x * 8) {
        const float rs = rstd_of(ss[row]);
#pragma unroll
        for (int j = 0; j < 4; ++j) {
            const u32x4 xw = *(const u32x4*)(xb + (size_t)row * 2048 + j * 512 + lane * 8);
            const f32x4 g0 = *(const f32x4*)(p.final_norm_g + j * 512 + lane * 8), g1 = *(const f32x4*)(p.final_norm_g + j * 512 + lane * 8 + 4);
            float* o = p.out + OFF_Y + (size_t)row * 2048 + j * 512 + lane * 8;
            *(f32x4*)o = (f32x4){bflo(xw.x), bfhi(xw.x), bflo(xw.y), bfhi(xw.y)} * rs * g0;
            *(f32x4*)(o + 4) = (f32x4){bflo(xw.z), bfhi(xw.z), bflo(xw.w), bfhi(xw.w)} * rs * g1;
        }
    }
}

#define XB_TMO      128
#define XB_XCNT(j)  (256  + 64 * (j))
#define XB_XSUB(j)  (1280 + 64 * (j))
#define XB_XGEN(j)  (2304 + 64 * (j))
#define XB_TOP      3328
#define XB_TOPGEN   3392
#define XB_QUEUE    3520
#define XB_SPIN_CAP (1u << 20)
__device__ __forceinline__ unsigned xb_ld(unsigned* p)              { return __hip_atomic_load(p, __ATOMIC_RELAXED, __HIP_MEMORY_SCOPE_AGENT); }
__device__ __forceinline__ unsigned xb_add(unsigned* p, unsigned v) { return __hip_atomic_fetch_add(p, v, __ATOMIC_RELAXED, __HIP_MEMORY_SCOPE_AGENT); }
__device__ __forceinline__ unsigned xb_xcc_id() { return (unsigned)__builtin_amdgcn_s_getreg((3 << 11) | 20) & 0xFu; }
#define XB_SPIN(cond, bar) do { unsigned _sp = 0; while (cond) { __builtin_amdgcn_s_sleep(1); \
    if ((++_sp & 255u) == 0u) { if (xb_ld(&(bar)[XB_TMO])) break; if (_sp > XB_SPIN_CAP) { atomicAdd(&(bar)[XB_TMO], 1u); break; } } } } while (0)
struct XcdBarrier { unsigned* bar; unsigned x; volatile LAS unsigned* st; };
__device__ __forceinline__ void xcd_barrier_complete(unsigned* bar, unsigned x, unsigned& nloc, unsigned& nx) {
    const unsigned G = gridDim.x;
    unsigned sum, cnt, mine, sp = 0u;
    for (;;) {
        sum = 0u; cnt = 0u; mine = 0u;
#pragma unroll
        for (unsigned j = 0; j < 16; ++j) { const unsigned c = xb_ld(&bar[XB_XCNT(j)]); sum += c; cnt += (c > 0u) ? 1u : 0u; mine = (j == x) ? c : mine; }
        if (sum == G) break;
        __builtin_amdgcn_s_sleep(1);
        if ((++sp & 255u) == 0u) { if (xb_ld(&bar[XB_TMO])) break; if (sp > XB_SPIN_CAP) { atomicAdd(&bar[XB_TMO], 1u); break; } }
    }
    nloc = mine > 0u ? mine : 1u; nx = cnt > 0u ? cnt : 1u;
}
__device__ __forceinline__ void grid_barrier(const XcdBarrier& b) {
    asm volatile("s_waitcnt vmcnt(0)" ::: "memory");
    __syncthreads();
    if (threadIdx.x == 0) {
        unsigned* bar = b.bar;
        __builtin_amdgcn_s_waitcnt(0);
        unsigned nloc = b.st[0], nx = b.st[1];
        if (nloc == 0u) { xcd_barrier_complete(bar, b.x, nloc, nx); b.st[0] = nloc; b.st[1] = nx; }
        const unsigned old = xb_add(&bar[XB_XSUB(b.x)], 1u);
        const unsigned gen = old / nloc;
        if (old + 1u == (gen + 1u) * nloc) {
            __builtin_amdgcn_fence(__ATOMIC_RELEASE, "agent");
            asm volatile("s_waitcnt vmcnt(0)" ::: "memory");
            const unsigned og = xb_add(&bar[XB_TOP], 1u);
            const unsigned tg = og / nx;
            if (og + 1u == (tg + 1u) * nx) xb_add(&bar[XB_TOPGEN], 1u);
            else XB_SPIN(xb_ld(&bar[XB_TOPGEN]) == tg, bar);
            __builtin_amdgcn_fence(__ATOMIC_ACQUIRE, "agent");
            xb_add(&bar[XB_XGEN(b.x)], 1u);
            asm volatile("s_waitcnt vmcnt(0)" ::: "memory");
        } else {
            XB_SPIN(xb_ld(&bar[XB_XGEN(b.x)]) == gen, bar);
            __builtin_amdgcn_fence(__ATOMIC_ACQUIRE, "agent");
            asm volatile("s_waitcnt vmcnt(0)" ::: "memory");
        }
    }
    __syncthreads();
}

__device__ __forceinline__ int queue_next(unsigned* ctr, LAS int* slot) {
    __syncthreads();
    if (threadIdx.x == 0) *slot = (int)__hip_atomic_fetch_add(ctr, 1u, __ATOMIC_RELAXED, __HIP_MEMORY_SCOPE_AGENT);
    __syncthreads();
    return *slot;
}

__global__ void __launch_bounds__(NTHREADS) fwd_megakernel(Params p) {
    extern __shared__ __attribute__((aligned(16))) unsigned char lds_raw[];
    LAS unsigned char* lds = (LAS unsigned char*)lds_raw;
    cg::grid_group grid = cg::this_grid();
    unsigned* bar = (unsigned*)(p.ws + WS_BAR);
    LAS int* qslot = (LAS int*)(lds + 131072);
    XcdBarrier xb; xb.bar = bar; xb.x = xb_xcc_id(); xb.st = (volatile LAS unsigned*)(lds + 131072 + 16);
    if (threadIdx.x == 0) { xb.st[0] = 0u; xb.st[1] = 0u; (void)xb_add(&bar[XB_XCNT(xb.x)], 1u); }
    __syncthreads();
    grid.sync();
    phase_prep(p, lds);
    if (PROBE_DUP & 1) { grid_barrier(xb); phase_prep(p, lds); }
    grid_barrier(xb);
#pragma unroll 1
    for (int l = 0; l < DEPTH; ++l) {
        const int bx = blockIdx.x;
        {
            const int grp = (bx >> 3) & 1;
#pragma unroll 1
            for (int pass = 0; pass < 2; ++pass) {
                if (pass == grp) for (int c = bx; c < 256; c += gridDim.x) lr_item(p, l, c, lds);
                if (pass == 0) gemm_phase<0>(lds, p, l, -1);
            }
        }
        grid_barrier(xb);
#pragma unroll 1
        for (int sub = 0; sub < 2; ++sub) {
            int start, hi, step;
            if (sub == 0) {
                if (bx < 48) gemm_phase<0>(lds, p, l, bx);
                else if (bx < 56) lr_item(p, l, 256 + bx - 48, lds);
                hi = 832; step = 208; start = (bx < 48) ? hi : bx - 48;
            } else {
                hi = 1024; step = 256; start = (bx >= 48) ? 832 + bx - 48 : hi;
                asm volatile("s_waitcnt vmcnt(0)" ::: "memory");
                __syncthreads();
                if (threadIdx.x == 0) { __builtin_amdgcn_fence(__ATOMIC_ACQUIRE, "agent"); asm volatile("s_waitcnt vmcnt(0)" ::: "memory"); }
                __syncthreads();
            }
            for (int it = start; it < hi; it += step) gla_local_item(p, l, it >> 2, it & 3, lds);
        }
        grid_barrier(xb);
#pragma unroll 1
        for (int sub = 0; sub < 2; ++sub) {
            unsigned* qc = bar + XB_QUEUE + l * 8 + 2;
#pragma unroll 1
            for (int n = 0;; ++n) {
                int code;
                if (sub == 0) {
                    const int q = queue_next(qc, qslot);
                    if (q >= 496) break;
                    code = (q < 400) ? q : (q < 432 ? 64 + 512 + (q - 400) : (q < 464 ? 608 + (q - 432) : 640 + (q - 464)));
                } else {
                    if (bx < 16) { if (n > 0) break; code = 3000 + bx; }
                    else {
                        const int k = bx - 16;
                        if (n < 4) code = 1000 + k + 240 * n;
                        else if (n == 4) code = (k < 64) ? 1000 + k + 960 : 64 + 336 + (k - 64);
                        else break;
                    }
                }
                if (code < 64) scan_task(p, l, code, lds);
                else if (code < 608) gmlp_item(p, l, (code - 64) >> 2, (code - 64) & 3, lds);
                else if (code < 640) gla_out_item<true>(p, l, 256 + ((code - 608) >> 2), (code - 608) & 3, lds);
                else if (code < 672) gla_sample_state_item(p, l, code - 640, lds);
                else if (code < 3000) gla_out_item<false>(p, l, (code - 1000) >> 2, (code - 1000) & 3, lds);
                else gemm_phase<1>(lds, p, l, code - 3000);
            }
            grid_barrier(xb);
        }
        gemm_phase<1>(lds, p, l, -1);
        grid_barrier(xb);
    }
    phase_final(p);
}

extern "C" void kernel_launch(void* const* d_in, const int* in_sizes, int n_in, void* d_out, int out_size, void* d_ws, size_t ws_size, hipStream_t stream) {
    static int grid = 0;
    if (grid == 0) {
        if (n_in != 14 || ws_size < WS_END) { fprintf(stderr, "kernel_launch: unexpected n_in %d / ws_size %zu (need %zu)\n", n_in, ws_size, (size_t)WS_END); grid = -1; return; }
        int dev = 0, cus = 0, per_cu = 0;
        (void)hipGetDevice(&dev);
        (void)hipDeviceGetAttribute(&cus, hipDeviceAttributeMultiprocessorCount, dev);
        if (hipFuncSetAttribute((const void*)fwd_megakernel, hipFuncAttributeMaxDynamicSharedMemorySize, LDS_BYTES) != hipSuccess) { fprintf(stderr, "kernel_launch: hipFuncSetAttribute failed\n"); grid = -1; return; }
        (void)hipOccupancyMaxActiveBlocksPerMultiprocessor(&per_cu, (const void*)fwd_megakernel, NTHREADS, LDS_BYTES);
        (void)hipGetLastError();
        if (per_cu < 1) { fprintf(stderr, "kernel_launch: occupancy query says %d blocks per CU\n", per_cu); per_cu = 1; }
        grid = cus;
    }
    if (grid < 0) return;
    (void)hipMemsetAsync((unsigned char*)d_ws + WS_BAR, 0, 16384, stream);
    Params p{};
    p.x_prompt = (const float*)d_in[0]; p.x_sample = (const float*)d_in[1]; p.state_gla = (const float*)d_in[2]; p.w_in = (const float*)d_in[3];
    p.w_gate_up = (const float*)d_in[4]; p.b_gate = (const float*)d_in[5]; p.w_s = (const float*)d_in[6]; p.b_s = (const float*)d_in[7];
    p.norm_g = (const float*)d_in[8]; p.gla_norm_g = (const float*)d_in[9]; p.mlp_ln_g = (const float*)d_in[10]; p.mlp_ln_b = (const float*)d_in[11];
    p.w_out = (const float*)d_in[12]; p.final_norm_g = (const float*)d_in[13];
    p.out = (float*)d_out; p.ws = (unsigned char*)d_ws;
    void* args[] = {&p};
    hipError_t e = hipLaunchCooperativeKernel((const void*)fwd_megakernel, dim3(grid), dim3(NTHREADS), args, LDS_BYTES, stream);
    if (e != hipSuccess) fprintf(stderr, "cooperative launch failed: %s (grid %d)\n", hipGetErrorString(e), grid);
}
```

```cpp
#include <hip/hip_runtime.h>
#include <hip/hip_cooperative_groups.h>
#include <cstdio>
#include <cstdint>
namespace cg = cooperative_groups;

#define LAS __attribute__((address_space(3)))
typedef unsigned short u16;
typedef short bf16x8 __attribute__((ext_vector_type(8)));
typedef float f32x4 __attribute__((ext_vector_type(4)));
typedef unsigned u32x4 __attribute__((ext_vector_type(4)));
typedef unsigned u32x2 __attribute__((ext_vector_type(2)));

constexpr int T = 16896, TP = 16384, DM = 2048, DEPTH = 4, DIN = 6160;
constexpr int NZROWS = 6400;
constexpr int NCH = 264;
constexpr int NTHREADS = 512;
#ifndef PROBE_DUP
#define PROBE_DUP 0
#endif
constexpr int LDS_BYTES = 131072 + 256 + 1024;
constexpr float EPS = 1e-6f;
constexpr float SS_SCALE = 1048576.f, SS_INV = 1.f / (1048576.f * 2048.f);
typedef unsigned long long u64;
__device__ __forceinline__ float rstd_of(u64 s) { return rsqrtf((float)s * SS_INV + EPS); }

constexpr size_t AL(size_t x) { return (x + 255) & ~(size_t)255; }
constexpr size_t WS_WTIN = 0;
constexpr size_t WS_WTOUT = WS_WTIN + AL((size_t)DEPTH * NZROWS * 2048 * 2);
constexpr size_t WS_XRES = WS_WTOUT + AL((size_t)DEPTH * 2048 * 2048 * 2);
constexpr size_t WS_XB = WS_XRES + AL((size_t)T * 2048 * 4);
constexpr size_t WS_ZQ = WS_XB + AL((size_t)T * 2048 * 2);
constexpr size_t WS_ZK = WS_ZQ + AL((size_t)T * 512 * 2);
constexpr size_t WS_ZVT = WS_ZK + AL((size_t)T * 512 * 2);
constexpr size_t WS_ZGA = WS_ZVT + AL((size_t)T * 1024 * 2);
constexpr size_t WS_ZU = WS_ZGA + AL((size_t)T * 1024 * 2);
constexpr size_t WS_ZVMT = WS_ZU + AL((size_t)T * 1024 * 2);
constexpr size_t WS_ZGB = WS_ZVMT + AL((size_t)T * 1024 * 2);
constexpr size_t WS_ZLR = WS_ZGB + AL((size_t)T * 1024 * 2);
constexpr size_t WS_UT = WS_ZLR + AL((size_t)T * 16 * 4);
constexpr size_t WS_SP = WS_UT + AL((size_t)NCH * 4 * 32768 * 2);
constexpr size_t WS_DEC = WS_SP + AL((size_t)NCH * 4 * 32768 * 2);
constexpr size_t WS_OBUF = WS_DEC + AL((size_t)NCH * 4 * 128 * 4);
constexpr size_t WS_SUMSQ = WS_OBUF + AL((size_t)T * 2048 * 2);
constexpr size_t WS_BAR = WS_SUMSQ + AL((size_t)5 * T * 8);
constexpr size_t WS_BCUM = WS_BAR + 16384;
constexpr size_t WS_WSB = WS_BCUM + AL((size_t)T * 512 * 4);
constexpr size_t WS_END = WS_WSB + AL((size_t)DEPTH * 4 * 128 * 128 * 2);

constexpr size_t OFF_Y = 0;
constexpr size_t OFF_GSP = (size_t)T * 2048;
constexpr size_t OFF_GSS = OFF_GSP + (size_t)DEPTH * 4 * 32768;
constexpr size_t OFF_MVS = OFF_GSS + (size_t)DEPTH * 8 * 4 * 32768;

struct Params {
    const float *x_prompt, *x_sample, *state_gla, *w_in, *w_gate_up, *b_gate, *w_s, *b_s, *norm_g, *gla_norm_g, *mlp_ln_g, *mlp_ln_b, *w_out, *final_norm_g;
    float* out; unsigned char* ws;
};

__device__ __forceinline__ unsigned cvt_pk_bf16(float lo, float hi) { unsigned r; asm("v_cvt_pk_bf16_f32 %0, %1, %2" : "=v"(r) : "v"(lo), "v"(hi)); return r; }
__device__ __forceinline__ u16 f2bf(float f) { return (u16)(cvt_pk_bf16(f, 0.f) & 0xffffu); }
__device__ __forceinline__ float bf2f(u16 b) { return __uint_as_float(((unsigned)b) << 16); }
__device__ __forceinline__ float bflo(unsigned w) { return __uint_as_float(w << 16); }
__device__ __forceinline__ float bfhi(unsigned w) { return __uint_as_float(w & 0xffff0000u); }
__device__ __forceinline__ float silu(float x) { return x / (1.f + __expf(-x)); }

__device__ __forceinline__ void phase_prep(const Params& p, LAS unsigned char* lds) {
    int tid = threadIdx.x; asm volatile("" : "+v"(tid));
    const int lane = tid & 63, wid = tid >> 6;
    unsigned char* ws = p.ws;
    u64* sumsq = (u64*)(ws + WS_SUMSQ);
    for (int i = blockIdx.x * NTHREADS + tid; i < 4 * T; i += gridDim.x * NTHREADS) sumsq[T + i] = 0ull;
    u16* xb = (u16*)(ws + WS_XB);
    for (int row = blockIdx.x * 8 + wid; row < T; row += gridDim.x * 16) {
        const int row2 = row + gridDim.x * 8; const bool has2 = row2 < T;
        const float* xr = row < TP ? p.x_prompt + (size_t)row * 2048 : p.x_sample + (size_t)(row - TP) * 2048;
        const float* xr2 = has2 ? (row2 < TP ? p.x_prompt + (size_t)row2 * 2048 : p.x_sample + (size_t)(row2 - TP) * 2048) : xr;
        f32x4 va[8], vb[8];
#pragma unroll
        for (int j = 0; j < 8; ++j) { va[j] = *(const f32x4*)(xr + j * 256 + lane * 4); vb[j] = *(const f32x4*)(xr2 + j * 256 + lane * 4); }
        float ss = 0.f, ss2 = 0.f;
#pragma unroll
        for (int j = 0; j < 8; ++j) {
            ss += va[j][0] * va[j][0] + va[j][1] * va[j][1] + va[j][2] * va[j][2] + va[j][3] * va[j][3];
            ss2 += vb[j][0] * vb[j][0] + vb[j][1] * vb[j][1] + vb[j][2] * vb[j][2] + vb[j][3] * vb[j][3];
            u32x2 w; w.x = cvt_pk_bf16(va[j][0], va[j][1]); w.y = cvt_pk_bf16(va[j][2], va[j][3]);
            *(u32x2*)(xb + (size_t)row * 2048 + j * 256 + lane * 4) = w;
            if (has2) { u32x2 w2; w2.x = cvt_pk_bf16(vb[j][0], vb[j][1]); w2.y = cvt_pk_bf16(vb[j][2], vb[j][3]);
                *(u32x2*)(xb + (size_t)row2 * 2048 + j * 256 + lane * 4) = w2; }
        }
#pragma unroll
        for (int o = 32; o >= 1; o >>= 1) { ss += __shfl_xor(ss, o); ss2 += __shfl_xor(ss2, o); }
        if (lane == 0) { sumsq[row] = (u64)(ss * SS_SCALE); if (has2) sumsq[row2] = (u64)(ss2 * SS_SCALE); }
    }
    for (int e = blockIdx.x * NTHREADS + tid; e < DEPTH * 2048 * 16; e += gridDim.x * NTHREADS) {
        const int l = e / (2048 * 16), r = e % (2048 * 16), k = r >> 4, n = r & 15;
        const float v = p.w_in[((size_t)l * 2048 + k) * DIN + 3072 + n] * p.norm_g[l * 2048 + k];
        ((u16*)(ws + WS_WTIN))[((size_t)l * NZROWS + 6144 + n) * 2048 + k] = f2bf(v);
    }
    for (int e = blockIdx.x * NTHREADS + tid; e < DEPTH * 4 * 128 * 128; e += gridDim.x * NTHREADS) {
        const int t = (e >> 7) & 127, s = e & 127;
        ((u16*)(ws + WS_WSB))[e] = f2bf(s <= t ? p.w_s[e] : 0.f);
    }
    LAS float* tile = (LAS float*)lds;
#define PREP_DECODE(job, src, dst, ldsrc, k0, n0, srccol0, g) do { const int _l = (job) >> 10; int _r = (job) & 1023; int _kt, _nb; \
        if (_r < 768) { _kt = _r / 24; _nb = _r % 24; src = p.w_in + (size_t)_l * 2048 * DIN; ldsrc = DIN; srccol0 = _nb * 256 + (_nb >= 12 ? 16 : 0); \
            dst = (u16*)(ws + WS_WTIN) + (size_t)_l * NZROWS * 2048; g = p.norm_g + _l * 2048; } \
        else { _r -= 768; _kt = _r >> 3; _nb = _r & 7; src = p.w_out + (size_t)_l * 2048 * 2048; ldsrc = 2048; srccol0 = _nb * 256; \
            dst = (u16*)(ws + WS_WTOUT) + (size_t)_l * 2048 * 2048; g = nullptr; } \
        k0 = _kt * 64; n0 = _nb * 256; } while (0)
#define PREP_LOAD(job) do { const float* _src; u16* _dst; int _ld, _k0, _n0, _sc; const float* _g; PREP_DECODE(job, _src, _dst, _ld, _k0, _n0, _sc, _g); (void)_dst; (void)_n0; \
        _Pragma("unroll") for (int i = 0; i < 8; ++i) { const int e = tid + i * 512, rr = e >> 6, c4 = (e & 63) * 4; \
            v[i] = *(const f32x4*)(_src + (size_t)(_k0 + rr) * _ld + _sc + c4); gv[i] = _g ? _g[_k0 + rr] : 1.f; } } while (0)
    {
        f32x4 v[8]; float gv[8];
        int job = blockIdx.x;
        if (job < DEPTH * 1024) PREP_LOAD(job);
        for (; job < DEPTH * 1024; job += gridDim.x) {
            const float* src; u16* dst; int ldsrc, k0, n0, srccol0; const float* g;
            PREP_DECODE(job, src, dst, ldsrc, k0, n0, srccol0, g); (void)src; (void)ldsrc; (void)srccol0; (void)g;
#pragma unroll
            for (int i = 0; i < 8; ++i) { const int e = tid + i * 512, rr = e >> 6, c4 = (e & 63) * 4;
#pragma unroll
                for (int j = 0; j < 4; ++j) tile[rr * 257 + c4 + j] = v[i][j] * gv[i]; }
            const int nextjob = job + gridDim.x;
            if (nextjob < DEPTH * 1024) PREP_LOAD(nextjob);
            __syncthreads();
#pragma unroll
            for (int i = 0; i < 4; ++i) { const int e = tid + i * 512, n = e >> 3, ko = (e & 7) * 8;
                u32x4 wv;
                wv.x = cvt_pk_bf16(tile[(ko + 0) * 257 + n], tile[(ko + 1) * 257 + n]); wv.y = cvt_pk_bf16(tile[(ko + 2) * 257 + n], tile[(ko + 3) * 257 + n]);
                wv.z = cvt_pk_bf16(tile[(ko + 4) * 257 + n], tile[(ko + 5) * 257 + n]); wv.w = cvt_pk_bf16(tile[(ko + 6) * 257 + n], tile[(ko + 7) * 257 + n]);
                *(u32x4*)(dst + (size_t)(n0 + n) * 2048 + k0 + ko) = wv; }
            __syncthreads();
        }
    }
#undef PREP_DECODE
#undef PREP_LOAD
}

constexpr int BM = 256, BK = 64, HALF = 128, HTB = HALF * BK * 2, NXCD = 8, WGM = 8;
__device__ __forceinline__ int lds_byte(int r, int c) { const int st = (r >> 4) * 2 + (c >> 5), rr = r & 15, cc = c & 31, ob = rr * 64 + cc * 2; return st * 1024 + (ob ^ (((ob >> 9) & 1) << 5)); }
__device__ __forceinline__ void stage_rc(int b, int& R, int& C) { const int st = b / 1024, sb = b % 1024, swz = sb ^ (((sb >> 9) & 1) << 5); R = (st >> 1) * 16 + swz / 64; C = (st & 1) * 32 + (swz % 64) / 2; }
__device__ __forceinline__ int perm32(int rho) { const int n = rho >> 4, i = rho & 15; return 8 * (i >> 2) + 4 * n + (i & 3); }
struct Unit { int pm, pn; };
__device__ __forceinline__ bool unit_next(int i, int G, int c, int nM, int nN, Unit& u) {
    const int nwg = nM * nN; const long L = (long)i * G + c; if (L >= nwg) return false;
    int wgid = (int)L; { const int q = nwg / NXCD, r = nwg % NXCD, xcd = wgid % NXCD, off = wgid / NXCD; wgid = (xcd < r ? xcd * (q + 1) : r * (q + 1) + (xcd - r) * q) + off; }
    const int nig = WGM * nN, gid = wgid / nig, fm = gid * WGM, gsz = (nM - fm) < WGM ? (nM - fm) : WGM;
    u.pm = fm + ((wgid % nig) % gsz); u.pn = (wgid % nig) / gsz; return true;
}
template <int MODE> __device__ __forceinline__ bool unit_swapped(const Unit& u) { return MODE == 0 && ((u.pn >= 4 && u.pn < 8) || (u.pn >= 16 && u.pn < 20)); }
template <int MODE> __device__ __forceinline__ void unit_ptrs(const char* act, const char* wt, const Unit& u, const char*& a, const char*& b) {
    const size_t tstep = (size_t)256 * 2048 * 2;
    const char* pa = act + (size_t)u.pm * tstep; const char* pb = wt + (size_t)u.pn * tstep;
    const bool sw = unit_swapped<MODE>(u);
    a = sw ? pb : pa; b = sw ? pa : pb;
}

template <int MODE>
__device__ __forceinline__ void gemm_epilogue(const Params& p, int l, const f32x4 (&acc)[2][2][4][2], const Unit& u, int wr, int wc, int fr, int fq, const LAS float* rl, int pm0) {
    unsigned char* ws = p.ws;
    const __amdgpu_buffer_rsrc_t wsr = __builtin_amdgcn_make_buffer_rsrc((void*)ws, (short)0, (int)WS_END, 0x00020000);
#define WT_STORE16(ptr, val) __builtin_amdgcn_raw_buffer_store_b128((val), wsr, (int)((const char*)(ptr) - (const char*)ws), 0, 16)
    if (MODE == 0) {
        const u64* ss = (const u64*)(ws + WS_SUMSQ) + (size_t)l * T;
        if (!unit_swapped<0>(u)) {
            const int pn = u.pn;
            u16* ob; int ld;
            if (pn < 2) { ob = (u16*)(ws + WS_ZQ) + pn * 256; ld = 512; }
            else if (pn < 4) { ob = (u16*)(ws + WS_ZK) + (pn - 2) * 256; ld = 512; }
            else if (pn < 12) { ob = (u16*)(ws + WS_ZGA) + (pn - 8) * 256; ld = 1024; }
            else if (pn < 16) { ob = (u16*)(ws + WS_ZU) + (pn - 12) * 256; ld = 1024; }
            else { ob = (u16*)(ws + WS_ZGB) + (pn - 20) * 256; ld = 1024; }
#pragma unroll
            for (int ai = 0; ai < 2; ++ai)
#pragma unroll
                for (int m = 0; m < 4; ++m) {
                    const int tok = u.pm * 256 + 128 * ai + 64 * wr + 16 * m + fr;
                    const float rs = (u.pm == pm0) ? rl[128 * ai + 64 * wr + 16 * m + fr] : rstd_of(ss[tok]);
#pragma unroll
                    for (int bj = 0; bj < 2; ++bj) {
                        const f32x4 v0 = acc[ai][bj][m][0] * rs, v1 = acc[ai][bj][m][1] * rs;
                        u32x4 w; w.x = cvt_pk_bf16(v0[0], v0[1]); w.y = cvt_pk_bf16(v0[2], v0[3]); w.z = cvt_pk_bf16(v1[0], v1[1]); w.w = cvt_pk_bf16(v1[2], v1[3]);
                        WT_STORE16(ob + (size_t)tok * ld + 128 * bj + 32 * wc + 8 * fq, w);
                    }
                }
        } else {
            u16* ob = (u.pn < 8) ? (u16*)(ws + WS_ZVT) + (size_t)((u.pn - 4) * 256) * T : (u16*)(ws + WS_ZVMT) + (size_t)((u.pn - 16) * 256) * T;
#pragma unroll
            for (int bj = 0; bj < 2; ++bj) {
                const int tok0 = u.pm * 256 + 128 * bj + 32 * wc + 8 * fq;
                f32x4 s0, s1;
#pragma unroll
                for (int e = 0; e < 4; ++e) { s0[e] = (u.pm == pm0) ? rl[128 * bj + 32 * wc + 8 * fq + e] : rstd_of(ss[tok0 + e]); s1[e] = (u.pm == pm0) ? rl[128 * bj + 32 * wc + 8 * fq + 4 + e] : rstd_of(ss[tok0 + 4 + e]); }
#pragma unroll
                for (int ai = 0; ai < 2; ++ai)
#pragma unroll
                    for (int m = 0; m < 4; ++m) {
                        const int zr = 128 * ai + 64 * wr + 16 * m + fr;
                        const f32x4 v0 = acc[ai][bj][m][0] * s0, v1 = acc[ai][bj][m][1] * s1;
                        u32x4 w; w.x = cvt_pk_bf16(v0[0], v0[1]); w.y = cvt_pk_bf16(v0[2], v0[3]); w.z = cvt_pk_bf16(v1[0], v1[1]); w.w = cvt_pk_bf16(v1[2], v1[3]);
                        WT_STORE16(ob + (size_t)zr * T + tok0, w);
                    }
            }
        }
    } else {
        u16* xb = (u16*)(ws + WS_XB);
        u64* ssn = (u64*)(ws + WS_SUMSQ) + (size_t)(l + 1) * T;
#pragma unroll
        for (int ai = 0; ai < 2; ++ai)
#pragma unroll
            for (int m = 0; m < 4; ++m) {
                const int tok = u.pm * 256 + 128 * ai + 64 * wr + 16 * m + fr;
                float part = 0.f;
#pragma unroll
                for (int bj = 0; bj < 2; ++bj) {
                    const size_t idx = (size_t)tok * 2048 + u.pn * 256 + 128 * bj + 32 * wc + 8 * fq;
                    const u32x4 xw = *(const u32x4*)(xb + idx);
                    f32x4 y0 = (f32x4){bflo(xw.x), bfhi(xw.x), bflo(xw.y), bfhi(xw.y)}, y1 = (f32x4){bflo(xw.z), bfhi(xw.z), bflo(xw.w), bfhi(xw.w)};
                    y0 += acc[ai][bj][m][0]; y1 += acc[ai][bj][m][1];
                    part += y0[0] * y0[0] + y0[1] * y0[1] + y0[2] * y0[2] + y0[3] * y0[3] + y1[0] * y1[0] + y1[1] * y1[1] + y1[2] * y1[2] + y1[3] * y1[3];
                    u32x4 w; w.x = cvt_pk_bf16(y0[0], y0[1]); w.y = cvt_pk_bf16(y0[2], y0[3]); w.z = cvt_pk_bf16(y1[0], y1[1]); w.w = cvt_pk_bf16(y1[2], y1[3]);
                    WT_STORE16(xb + idx, w);
                }
                part += __shfl_xor(part, 16); part += __shfl_xor(part, 32);
                if (fq == 0) atomicAdd(ssn + tok, (u64)(part * SS_SCALE));
            }
    }
}

#undef WT_STORE16
template <int MODE>
__device__ __forceinline__ void gemm_phase(LAS unsigned char* lds, const Params& p, int l, int single) {
    int tid = threadIdx.x; asm volatile("" : "+v"(tid)); asm volatile("" : "+s"(l));
    const int wid = __builtin_amdgcn_readfirstlane(tid >> 6), lane = tid & 63, wr = wid >> 2, wc = wid & 3, fr = lane & 15, fq = lane >> 4;
    constexpr int K = 2048, nt = K / BK;
    const int nM = TP / 256, nN = (MODE == 0) ? 24 : 8, G = gridDim.x, cidx = blockIdx.x;
    const char* act = (MODE == 0) ? (const char*)(p.ws + WS_XB) : (const char*)(p.ws + WS_OBUF);
    const char* wt = (MODE == 0) ? (const char*)(p.ws + WS_WTIN) + (size_t)l * NZROWS * 2048 * 2 : (const char*)(p.ws + WS_WTOUT) + (size_t)l * 2048 * 2048 * 2;
    unsigned voffA[2], voffB[2];
#pragma unroll
    for (int i = 0; i < 2; ++i) { int R, C; stage_rc(tid * 16 + i * 8192, R, C); const int Rb = (R & ~31) + perm32(R & 31);
        voffA[i] = (unsigned)(R * K + C) * 2u; voffB[i] = (unsigned)(Rb * K + C) * 2u; }
    const size_t kstep = (size_t)(BK * 2);
    const size_t hstep = (size_t)HALF * K * 2;
    const unsigned ldsw = (unsigned)wid * 1024u;
    const int aoff = lds_byte(wr * 64 + fr, fq * 8), boff = lds_byte(wc * 32 + fr, fq * 8);
#define PG8_SA(b, h) (((b) * 2 + (h)) * HTB)
#define PG8_SB(b, h) ((4 + (b) * 2 + (h)) * HTB)
#define PG8_STAGE(bufoff, gbase, voff) do { _Pragma("unroll") for (int _i = 0; _i < 2; ++_i) \
        __builtin_amdgcn_global_load_lds((const unsigned*)((const char*)(gbase) + (voff)[_i]), (LAS unsigned*)(lds + (bufoff) + ldsw + _i * 8192), 16, 0, 0); } while (0)
#define PG8_LDA(dst, b, h) do { _Pragma("unroll") for (int m = 0; m < 4; ++m) _Pragma("unroll") for (int k = 0; k < 2; ++k) dst[m][k] = *(const LAS bf16x8*)(lds + PG8_SA(b, h) + aoff + m * 2048 + k * 1024); } while (0)
#define PG8_LDB(dst, b, h) do { _Pragma("unroll") for (int n = 0; n < 2; ++n) _Pragma("unroll") for (int k = 0; k < 2; ++k) dst[n][k] = *(const LAS bf16x8*)(lds + PG8_SB(b, h) + boff + n * 2048 + k * 1024); } while (0)
#define PG8_MMA(ai, bj, At, Bt) do { __builtin_amdgcn_s_setprio(1); _Pragma("unroll") for (int m = 0; m < 4; ++m) _Pragma("unroll") for (int n = 0; n < 2; ++n) _Pragma("unroll") for (int k = 0; k < 2; ++k) \
        acc[ai][bj][m][n] = __builtin_amdgcn_mfma_f32_16x16x32_bf16(Bt[n][k], At[m][k], acc[ai][bj][m][n], 0, 0, 0); __builtin_amdgcn_s_setprio(0); } while (0)
#define PG8_WAIT_V(n) asm volatile("s_waitcnt vmcnt(" #n ")" ::: "memory")
#define PG8_WAIT_L(n) asm volatile("s_waitcnt lgkmcnt(" #n ")" ::: "memory")
#define PG8_BAR __builtin_amdgcn_s_barrier()
#define PG8_SCHED __builtin_amdgcn_sched_barrier(0)
    Unit cur, nxt; int ui = 0;
    if (single >= 0) { cur.pm = nM + single / nN; cur.pn = single % nN; }
    else if (!unit_next(0, G, cidx, nM, nN, cur)) return;
    LAS float* rl = (LAS float*)(lds + 131072 + 256);
    const int pm0 = cur.pm;
    if (MODE == 0) {
        if (tid < 256) rl[tid] = rstd_of(((const u64*)(p.ws + WS_SUMSQ))[(size_t)l * T + pm0 * 256 + tid]);
        __syncthreads();
    }
    f32x4 acc[2][2][4][2];
#pragma unroll
    for (int a = 0; a < 2; ++a)
#pragma unroll
        for (int b = 0; b < 2; ++b)
#pragma unroll
            for (int m = 0; m < 4; ++m)
#pragma unroll
                for (int n = 0; n < 2; ++n) acc[a][b][m][n] = (f32x4){0.f, 0.f, 0.f, 0.f};
    bf16x8 At[4][2], B0[2][2], B1[2][2];
    const char *cA, *cB; unit_ptrs<MODE>(act, wt, cur, cA, cB);
    PG8_STAGE(PG8_SB(0, 0), cB, voffB); PG8_STAGE(PG8_SA(0, 0), cA, voffA); PG8_STAGE(PG8_SB(0, 1), cB + hstep, voffB); PG8_STAGE(PG8_SA(0, 1), cA + hstep, voffA);
    if (wr == 1) PG8_BAR;
    PG8_WAIT_V(4); PG8_BAR;
    PG8_STAGE(PG8_SB(1, 0), cB + kstep, voffB); PG8_STAGE(PG8_SA(1, 0), cA + kstep, voffA); PG8_STAGE(PG8_SB(1, 1), cB + hstep + kstep, voffB);
    PG8_WAIT_V(6); PG8_BAR;
    for (;;) {
        const bool has_next = (single < 0) && unit_next(ui + 1, G, cidx, nM, nN, nxt);
        const char *nA = cA, *nB = cB;
        if (has_next) unit_ptrs<MODE>(act, wt, nxt, nA, nB);
        for (int t = 0; t < nt; t += 2) {
            const bool last = (t == nt - 2);
            const char* a1 = cA + (size_t)(t + 1) * kstep;
            const char* a2 = last ? nA : cA + (size_t)(t + 2) * kstep; const char* b2 = last ? nB : cB + (size_t)(t + 2) * kstep;
            const char* a3 = a2 + kstep; const char* b3 = b2 + kstep;
            PG8_LDB(B0, 0, 0); PG8_SCHED; PG8_LDA(At, 0, 0); PG8_STAGE(PG8_SA(1, 1), a1 + hstep, voffA);
            PG8_WAIT_L(8); PG8_BAR; PG8_WAIT_L(0); PG8_MMA(0, 0, At, B0); PG8_BAR; PG8_SCHED;
            PG8_LDB(B1, 0, 1); PG8_STAGE(PG8_SB(0, 0), b2, voffB);
            PG8_BAR; PG8_WAIT_L(0); PG8_MMA(0, 1, At, B1); PG8_BAR;
            PG8_LDA(At, 0, 1); PG8_STAGE(PG8_SA(0, 0), a2, voffA);
            PG8_BAR; PG8_WAIT_L(0); PG8_MMA(1, 0, At, B0); PG8_BAR; PG8_SCHED;
            PG8_STAGE(PG8_SB(0, 1), b2 + hstep, voffB);
            PG8_WAIT_V(6); PG8_BAR; PG8_MMA(1, 1, At, B1); PG8_BAR;
            PG8_LDB(B0, 1, 0); PG8_SCHED; PG8_LDA(At, 1, 0); PG8_STAGE(PG8_SA(0, 1), a2 + hstep, voffA);
            PG8_WAIT_L(8); PG8_BAR; PG8_WAIT_L(0); PG8_MMA(0, 0, At, B0); PG8_BAR; PG8_SCHED;
            PG8_LDB(B1, 1, 1); PG8_STAGE(PG8_SB(1, 0), b3, voffB);
            PG8_BAR; PG8_WAIT_L(0); PG8_MMA(0, 1, At, B1); PG8_BAR;
            PG8_LDA(At, 1, 1); PG8_STAGE(PG8_SA(1, 0), a3, voffA);
            PG8_BAR; PG8_WAIT_L(0); PG8_MMA(1, 0, At, B0); PG8_BAR; PG8_SCHED;
            PG8_STAGE(PG8_SB(1, 1), b3 + hstep, voffB);
            PG8_WAIT_V(6); PG8_BAR; PG8_MMA(1, 1, At, B1); PG8_BAR;
        }
        gemm_epilogue<MODE>(p, l, acc, cur, wr, wc, fr, fq, rl, pm0);
        if (!has_next) break;
#pragma unroll
        for (int a = 0; a < 2; ++a)
#pragma unroll
            for (int b = 0; b < 2; ++b)
#pragma unroll
                for (int m = 0; m < 4; ++m)
#pragma unroll
                    for (int n = 0; n < 2; ++n) acc[a][b][m][n] = (f32x4){0.f, 0.f, 0.f, 0.f};
        cur = nxt; cA = nA; cB = nB; ++ui;
    }
    PG8_WAIT_V(0);
    if (wr == 0) PG8_BAR;
    PG8_BAR;
#undef PG8_SA
#undef PG8_SB
#undef PG8_STAGE
#undef PG8_LDA
#undef PG8_LDB
#undef PG8_MMA
#undef PG8_WAIT_V
#undef PG8_WAIT_L
#undef PG8_BAR
#undef PG8_SCHED
}

__device__ __forceinline__ void gla_gates(const Params& p, int l, int h, int tok0, int d, int tg, LAS float* gsum, float (&b)[16], float& blast) {
    LAS float* lrs = gsum + 25088;
    {
        const int t2 = threadIdx.x;
        if (t2 < 256) *(LAS f32x4*)(lrs + t2 * 4) = *(const f32x4*)((const float*)(p.ws + WS_ZLR) + (size_t)tok0 * 16 + t2 * 4);
    }
    const float* wg = p.w_gate_up + (size_t)l * 16 * 512 + h * 128 + d;
    float w[16];
#pragma unroll
    for (int r = 0; r < 16; ++r) w[r] = wg[r * 512];
    const float bg = p.b_gate[l * 512 + h * 128 + d];
    __syncthreads();
    const LAS float* lr = lrs + (tg * 16) * 16;
    float run = 0.f;
#pragma unroll
    for (int i = 0; i < 16; ++i) {
        float x = bg;
#pragma unroll
        for (int r4 = 0; r4 < 4; ++r4) { const f32x4 a = *(const LAS f32x4*)(lr + i * 16 + r4 * 4);
            x += a[0] * w[r4 * 4] + a[1] * w[r4 * 4 + 1] + a[2] * w[r4 * 4 + 2] + a[3] * w[r4 * 4 + 3]; }
        const float ls = fminf(x, 0.f) - __logf(1.f + __expf(-fabsf(x)));
        run += ls * (1.f / 16.f); b[i] = run;
    }
    gsum[tg * 128 + d] = run;
    __syncthreads();
    float off = 0.f, tot = 0.f;
#pragma unroll
    for (int g = 0; g < 4; ++g) { const float v = gsum[g * 128 + d]; tot += v; if (g < tg) off += v; }
#pragma unroll
    for (int i = 0; i < 16; ++i) b[i] += off;
    blast = tot;
}

__device__ __forceinline__ void gla_local_item(const Params& p, int l, int c, int h, LAS unsigned char* lds) {
    int tid = threadIdx.x; asm volatile("" : "+v"(tid)); asm volatile("" : "+s"(l));
    const int lane = tid & 63, w = tid >> 6, fr = lane & 15, fq = lane >> 4, d = tid & 127, tg = tid >> 7;
    unsigned char* ws = p.ws;
    LAS float* gsum = (LAS float*)lds;
    LAS float* decl = (LAS float*)(lds + 2048);
    LAS unsigned char* kT = lds + 4096;
    const int tok0 = c * 64;
    const u16* kp = (const u16*)(ws + WS_ZK) + (size_t)(tok0 + tg * 16) * 512 + h * 128 + d;
    u16 kraw[16];
#pragma unroll
    for (int i = 0; i < 16; ++i) kraw[i] = kp[i * 512];
    const u16* vt = (const u16*)(ws + WS_ZVT) + (size_t)(h * 256 + w * 32 + fr) * T + tok0 + fq * 8;
    bf16x8 bv[2][2];
#pragma unroll
    for (int kk = 0; kk < 2; ++kk)
#pragma unroll
        for (int n = 0; n < 2; ++n) bv[kk][n] = *(const bf16x8*)(vt + (size_t)(n * 16) * T + kk * 32);
    float b[16], blast;
    gla_gates(p, l, h, tok0, d, tg, gsum, b, blast);
    {
        unsigned* bc = (unsigned*)((u16*)(ws + WS_BCUM) + (size_t)(tok0 + tg * 16) * 512 + h * 128 + (d & ~1));
#pragma unroll
        for (int i = 0; i < 16; ++i) {
            const float ev = __expf(b[i]);
            const float eo = __shfl_down(ev, 1);
            if ((d & 1) == 0) bc[i * 256] = cvt_pk_bf16(ev, eo);
        }
        unsigned pk[8];
#pragma unroll
        for (int i = 0; i < 8; ++i) {
            const float k0 = bf2f(kraw[2 * i]) * __expf(blast - b[2 * i]);
            const float k1 = bf2f(kraw[2 * i + 1]) * __expf(blast - b[2 * i + 1]);
            pk[i] = cvt_pk_bf16(k0, k1);
        }
        u32x4 w0, w1; w0.x = pk[0]; w0.y = pk[1]; w0.z = pk[2]; w0.w = pk[3]; w1.x = pk[4]; w1.y = pk[5]; w1.z = pk[6]; w1.w = pk[7];
        *(LAS u32x4*)(kT + d * 144 + tg * 32) = w0; *(LAS u32x4*)(kT + d * 144 + tg * 32 + 16) = w1;
        if (tg == 0) { const float dc = __expf(blast); decl[d] = dc; ((float*)(ws + WS_DEC))[(size_t)(c * 4 + h) * 128 + d] = dc; }
    }
    __syncthreads();
    f32x4 acc[8][2];
#pragma unroll
    for (int mt = 0; mt < 8; ++mt) { acc[mt][0] = (f32x4){0.f, 0.f, 0.f, 0.f}; acc[mt][1] = (f32x4){0.f, 0.f, 0.f, 0.f}; }
#pragma unroll
    for (int kk = 0; kk < 2; ++kk) {
#pragma unroll
        for (int mt = 0; mt < 8; ++mt) {
            const bf16x8 a = *(const LAS bf16x8*)(kT + (mt * 16 + fr) * 144 + (kk * 32 + fq * 8) * 2);
#pragma unroll
            for (int n = 0; n < 2; ++n) acc[mt][n] = __builtin_amdgcn_mfma_f32_16x16x32_bf16(a, bv[kk][n], acc[mt][n], 0, 0, 0);
        }
    }
    if (c < 256) {
        u16* ut = (u16*)(ws + WS_UT) + (size_t)(c * 4 + h) * 32768;
#pragma unroll
        for (int mt = 0; mt < 8; ++mt)
#pragma unroll
            for (int n = 0; n < 2; ++n) {
                u32x2 wv; wv.x = cvt_pk_bf16(acc[mt][n][0], acc[mt][n][1]); wv.y = cvt_pk_bf16(acc[mt][n][2], acc[mt][n][3]);
                *(u32x2*)(ut + (w * 32 + n * 16 + fr) * 128 + mt * 16 + fq * 4) = wv;
            }
    } else {
        const int s = c - 256;
        const size_t sidx = (((size_t)l * 8 + s) * 4 + h) * 32768;
        const float* s0 = p.state_gla + sidx;
        float* so = p.out + OFF_GSS + sidx;
        u16* sp = (u16*)(ws + WS_SP) + (size_t)(c * 4 + h) * 32768;
#pragma unroll
        for (int mt = 0; mt < 8; ++mt)
#pragma unroll
            for (int n = 0; n < 2; ++n) {
                const int dv = w * 32 + n * 16 + fr, dk0 = mt * 16 + fq * 4;
                float sv[4];
#pragma unroll
                for (int e = 0; e < 4; ++e) { sv[e] = s0[(dk0 + e) * 256 + dv]; so[(dk0 + e) * 256 + dv] = decl[dk0 + e] * sv[e] + acc[mt][n][e]; }
                u32x2 wv; wv.x = cvt_pk_bf16(sv[0], sv[1]); wv.y = cvt_pk_bf16(sv[2], sv[3]);
                *(u32x2*)(sp + dv * 128 + dk0) = wv;
            }
    }
    __syncthreads();
}

__device__ __forceinline__ void scan_task(const Params& p, int l, int j, LAS unsigned char* lds) {
    unsigned char* ws = p.ws;
    int tid = threadIdx.x; asm volatile("" : "+v"(tid)); asm volatile("" : "+s"(l));
    const int e = j * 2048 + tid * 4;
    const int h = e >> 15, dk = e & 127, dv = (e >> 7) & 255;
    const u16* ut = (const u16*)(ws + WS_UT) + e; u16* sp = (u16*)(ws + WS_SP) + e;
    LAS float* dl = (LAS float*)lds;
    {
        const float* dsrc = (const float*)(ws + WS_DEC) + h * 128;
#pragma unroll
        for (int i = 0; i < 16; ++i) { const int q = tid + i * 512, c = q >> 5, d4 = (q & 31) * 4; *(LAS f32x4*)(dl + c * 128 + d4) = *(const f32x4*)(dsrc + (size_t)c * 512 + d4); }
    }
    f32x4 S = (f32x4){0.f, 0.f, 0.f, 0.f};
    u32x2 uvA[16], uvB[16];
#define SCAN_LOAD(uv, cb) do { _Pragma("unroll") for (int i = 0; i < 16; ++i) uv[i] = *(const u32x2*)(ut + (size_t)((cb) + i) * 131072); } while (0)
#define SCAN_STEP(uv, cb) do { _Pragma("unroll") for (int i = 0; i < 16; ++i) { \
            const f32x4 dd = *(const LAS f32x4*)(dl + ((cb) + i) * 128 + dk); \
            u32x2 wv; wv.x = cvt_pk_bf16(S[0], S[1]); wv.y = cvt_pk_bf16(S[2], S[3]); \
            *(u32x2*)(sp + (size_t)((cb) + i) * 131072) = wv; \
            S[0] = dd[0] * S[0] + bflo(uv[i].x); S[1] = dd[1] * S[1] + bfhi(uv[i].x); \
            S[2] = dd[2] * S[2] + bflo(uv[i].y); S[3] = dd[3] * S[3] + bfhi(uv[i].y); } } while (0)
    SCAN_LOAD(uvA, 0);
    __syncthreads();
    for (int c0 = 0; c0 < 256; c0 += 32) {
        SCAN_LOAD(uvB, c0 + 16);
        SCAN_STEP(uvA, c0);
        if (c0 + 32 < 256) SCAN_LOAD(uvA, c0 + 32);
        SCAN_STEP(uvB, c0 + 16);
    }
#undef SCAN_LOAD
#undef SCAN_STEP
    float* go = p.out + OFF_GSP + ((size_t)l * 4 + h) * 32768 + dk * 256 + dv;
#pragma unroll
    for (int i = 0; i < 4; ++i) go[i * 256] = S[i];
}

template <bool SMP>
__device__ __forceinline__ void gla_out_item(const Params& p, int l, int c, int h, LAS unsigned char* lds) {
    int tid = threadIdx.x; asm volatile("" : "+v"(tid)); asm volatile("" : "+s"(l));
    const int lane = tid & 63, w = tid >> 6, fr = lane & 15, fq = lane >> 4, d = tid & 127, tg = tid >> 7;
    unsigned char* ws = p.ws;
    LAS float* red = (LAS float*)(lds + 2048);
    LAS unsigned char* Q = lds + 4096;
    LAS unsigned char* Kt = Q + 17408;
    LAS unsigned char* P = Kt + 17408;
    const int tok0 = c * 64;
    const size_t rowoff = (size_t)(tok0 + tg * 16) * 512 + h * 128 + d;
    const float* bc = (const float*)(ws + WS_BCUM) + rowoff;
    const u16* qp = (const u16*)(ws + WS_ZQ) + rowoff;
    const u16* kp = (const u16*)(ws + WS_ZK) + rowoff;
    float b[16]; u16 qraw[16], kraw[16];
    const int t8 = tid >> 3, dg = (tid & 7) * 16;
    u32x4 qw0, qw1, kw0, kw1, ew0, ew1;
    if (!SMP) {
        const size_t ro = (size_t)(tok0 + t8) * 512 + h * 128 + dg;
        qw0 = *(const u32x4*)((const u16*)(ws + WS_ZQ) + ro); qw1 = *(const u32x4*)((const u16*)(ws + WS_ZQ) + ro + 8);
        kw0 = *(const u32x4*)((const u16*)(ws + WS_ZK) + ro); kw1 = *(const u32x4*)((const u16*)(ws + WS_ZK) + ro + 8);
        ew0 = *(const u32x4*)((const u16*)(ws + WS_BCUM) + ro); ew1 = *(const u32x4*)((const u16*)(ws + WS_BCUM) + ro + 8);
    } else {
#pragma unroll
        for (int i = 0; i < 16; ++i) { qraw[i] = qp[i * 512]; kraw[i] = kp[i * 512]; }
    }
    const u16* vt = (const u16*)(ws + WS_ZVT) + (size_t)(h * 256 + w * 32 + fr) * T + tok0 + fq * 8;
    bf16x8 bv[2][2];
#pragma unroll
    for (int kk = 0; kk < 2; ++kk)
#pragma unroll
        for (int n = 0; n < 2; ++n) bv[kk][n] = *(const bf16x8*)(vt + (size_t)(n * 16) * T + kk * 32);
    const u16* sp = (const u16*)(ws + WS_SP) + (size_t)(c * 4 + h) * 32768 + (size_t)(w * 32 + fr) * 128 + fq * 8;
    bf16x8 bs[4][2];
    if (!SMP) {
#pragma unroll
        for (int kk = 0; kk < 4; ++kk)
#pragma unroll
            for (int n = 0; n < 2; ++n) bs[kk][n] = *(const bf16x8*)(sp + n * 16 * 128 + kk * 32);
    } else {
        const float* s0 = p.state_gla + (((size_t)l * 8 + (c - 256)) * 4 + h) * 32768 + w * 32 + fr;
#pragma unroll
        for (int kk = 0; kk < 4; ++kk)
#pragma unroll
            for (int n = 0; n < 2; ++n) {
                float sv[8];
#pragma unroll
                for (int j = 0; j < 8; ++j) sv[j] = s0[(size_t)(kk * 32 + fq * 8 + j) * 256 + n * 16];
                u32x4 pw; pw.x = cvt_pk_bf16(sv[0], sv[1]); pw.y = cvt_pk_bf16(sv[2], sv[3]); pw.z = cvt_pk_bf16(sv[4], sv[5]); pw.w = cvt_pk_bf16(sv[6], sv[7]);
                bs[kk][n] = __builtin_bit_cast(bf16x8, pw);
            }
    }
    u32x2 gav[4][2];
#pragma unroll
    for (int mt = 0; mt < 4; ++mt)
#pragma unroll
        for (int n = 0; n < 2; ++n) gav[mt][n] = *(const u32x2*)((const u16*)(ws + WS_ZGA) + (size_t)(tok0 + mt * 16 + fr) * 1024 + h * 256 + w * 32 + n * 16 + fq * 4);
    if (SMP) {
        float blast; gla_gates(p, l, h, tok0, d, tg, (LAS float*)lds, b, blast);
#pragma unroll
        for (int i = 0; i < 16; ++i) {
            const int t = tg * 16 + i;
            const float qv = bf2f(qraw[i]) * 0.08838834764831845f * __expf(b[i]);
            const float kv = bf2f(kraw[i]) * __expf(-b[i]);
            ((LAS u16*)Q)[t * 136 + d] = f2bf(qv); ((LAS u16*)Kt)[t * 136 + d] = f2bf(kv);
        }
    } else {
        const unsigned qq[8] = {qw0.x, qw0.y, qw0.z, qw0.w, qw1.x, qw1.y, qw1.z, qw1.w};
        const unsigned kk8[8] = {kw0.x, kw0.y, kw0.z, kw0.w, kw1.x, kw1.y, kw1.z, kw1.w};
        const unsigned ee[8] = {ew0.x, ew0.y, ew0.z, ew0.w, ew1.x, ew1.y, ew1.z, ew1.w};
        unsigned qo[8], ko[8];
#pragma unroll
        for (int j = 0; j < 8; ++j) {
            const float e0 = bflo(ee[j]), e1 = bfhi(ee[j]);
            const float q0 = bflo(qq[j]) * 0.08838834764831845f * e0, q1 = bfhi(qq[j]) * 0.08838834764831845f * e1;
            const float k0 = bflo(kk8[j]) * __builtin_amdgcn_rcpf(e0), k1 = bfhi(kk8[j]) * __builtin_amdgcn_rcpf(e1);
            qo[j] = cvt_pk_bf16(q0, q1); ko[j] = cvt_pk_bf16(k0, k1);
        }
        u32x4 w0, w1; w0.x = qo[0]; w0.y = qo[1]; w0.z = qo[2]; w0.w = qo[3]; w1.x = qo[4]; w1.y = qo[5]; w1.z = qo[6]; w1.w = qo[7];
        *(LAS u32x4*)(Q + t8 * 272 + dg * 2) = w0; *(LAS u32x4*)(Q + t8 * 272 + dg * 2 + 16) = w1;
        w0.x = ko[0]; w0.y = ko[1]; w0.z = ko[2]; w0.w = ko[3]; w1.x = ko[4]; w1.y = ko[5]; w1.z = ko[6]; w1.w = ko[7];
        *(LAS u32x4*)(Kt + t8 * 272 + dg * 2) = w0; *(LAS u32x4*)(Kt + t8 * 272 + dg * 2 + 16) = w1;
    }
    __syncthreads();
    {
        const int mt = w >> 1;
#pragma unroll
        for (int j = 0; j < 2; ++j) {
            const int nt = (w & 1) * 2 + j;
            f32x4 s = (f32x4){0.f, 0.f, 0.f, 0.f};
            if (nt <= mt) {
#pragma unroll
                for (int kk = 0; kk < 4; ++kk) {
                    const bf16x8 a = *(const LAS bf16x8*)(Q + (mt * 16 + fr) * 272 + (kk * 32 + fq * 8) * 2);
                    const bf16x8 bq = *(const LAS bf16x8*)(Kt + (nt * 16 + fr) * 272 + (kk * 32 + fq * 8) * 2);
                    s = __builtin_amdgcn_mfma_f32_16x16x32_bf16(a, bq, s, 0, 0, 0);
                }
            }
#pragma unroll
            for (int e = 0; e < 4; ++e) { const int t = mt * 16 + fq * 4 + e, si = nt * 16 + fr; ((LAS u16*)P)[t * 72 + si] = f2bf(si <= t ? s[e] : 0.f); }
        }
    }
    __syncthreads();
    f32x4 o[4][2];
#pragma unroll
    for (int mt = 0; mt < 4; ++mt) { o[mt][0] = (f32x4){0.f, 0.f, 0.f, 0.f}; o[mt][1] = (f32x4){0.f, 0.f, 0.f, 0.f}; }
#pragma unroll
    for (int kk = 0; kk < 2; ++kk) {
#pragma unroll
        for (int mt = 0; mt < 4; ++mt) {
            if (2 * kk <= mt) {
                const bf16x8 a = *(const LAS bf16x8*)(P + (mt * 16 + fr) * 144 + (kk * 32 + fq * 8) * 2);
#pragma unroll
                for (int n = 0; n < 2; ++n) o[mt][n] = __builtin_amdgcn_mfma_f32_16x16x32_bf16(bv[kk][n], a, o[mt][n], 0, 0, 0);
            }
        }
    }
#pragma unroll
    for (int kk = 0; kk < 4; ++kk) {
#pragma unroll
        for (int mt = 0; mt < 4; ++mt) {
            const bf16x8 a = *(const LAS bf16x8*)(Q + (mt * 16 + fr) * 272 + (kk * 32 + fq * 8) * 2);
#pragma unroll
            for (int n = 0; n < 2; ++n) o[mt][n] = __builtin_amdgcn_mfma_f32_16x16x32_bf16(bs[kk][n], a, o[mt][n], 0, 0, 0);
        }
    }
#pragma unroll
    for (int mt = 0; mt < 4; ++mt) {
        float s2 = 0.f;
#pragma unroll
        for (int n = 0; n < 2; ++n)
#pragma unroll
            for (int e = 0; e < 4; ++e) s2 += o[mt][n][e] * o[mt][n][e];
        s2 += __shfl_xor(s2, 16); s2 += __shfl_xor(s2, 32);
        if (fq == 0) red[w * 64 + mt * 16 + fr] = s2;
    }
    __syncthreads();
    const float* gn = p.gla_norm_g + l * 256 + w * 32 + fq * 4;
    const f32x4 g0 = *(const f32x4*)gn, g1 = *(const f32x4*)(gn + 16);
#pragma unroll
    for (int mt = 0; mt < 4; ++mt) {
        const int t = mt * 16 + fr;
        float tot = 0.f;
#pragma unroll
        for (int ww = 0; ww < 8; ++ww) tot += red[ww * 64 + t];
        const float rs = rsqrtf(tot * (1.f / 256.f) + EPS);
#pragma unroll
        for (int n = 0; n < 2; ++n) {
            const f32x4 gg = n ? g1 : g0; const u32x2 ga = gav[mt][n];
            const float o0 = o[mt][n][0] * rs * gg[0] * silu(bflo(ga.x)), o1 = o[mt][n][1] * rs * gg[1] * silu(bfhi(ga.x));
            const float o2 = o[mt][n][2] * rs * gg[2] * silu(bflo(ga.y)), o3 = o[mt][n][3] * rs * gg[3] * silu(bfhi(ga.y));
            u32x2 wv; wv.x = cvt_pk_bf16(o0, o1); wv.y = cvt_pk_bf16(o2, o3);
            *(u32x2*)((u16*)(ws + WS_OBUF) + (size_t)(tok0 + t) * 2048 + h * 256 + w * 32 + n * 16 + fq * 4) = wv;
        }
    }
    __syncthreads();
}

__device__ __forceinline__ void lr_item(const Params& p, int l, int c, LAS unsigned char* lds) {
    int tid = threadIdx.x; asm volatile("" : "+v"(tid)); asm volatile("" : "+s"(l));
    const int lane = tid & 63, w = tid >> 6, fr = lane & 15, fq = lane >> 4;
    unsigned char* ws = p.ws;
    const u16* xb = (const u16*)(ws + WS_XB) + (size_t)(c * 64) * 2048 + w * 256 + fq * 8;
    const u16* wl = (const u16*)(ws + WS_WTIN) + ((size_t)l * NZROWS + 6144 + fr) * 2048 + w * 256 + fq * 8;
    f32x4 acc[4];
#pragma unroll
    for (int mt = 0; mt < 4; ++mt) acc[mt] = (f32x4){0.f, 0.f, 0.f, 0.f};
#pragma unroll
    for (int kk = 0; kk < 8; ++kk) {
        const bf16x8 bw = *(const bf16x8*)(wl + kk * 32);
#pragma unroll
        for (int mt = 0; mt < 4; ++mt) {
            const bf16x8 a = *(const bf16x8*)(xb + (size_t)(mt * 16 + fr) * 2048 + kk * 32);
            acc[mt] = __builtin_amdgcn_mfma_f32_16x16x32_bf16(a, bw, acc[mt], 0, 0, 0);
        }
    }
    LAS float* red = (LAS float*)lds;
#pragma unroll
    for (int mt = 0; mt < 4; ++mt)
#pragma unroll
        for (int e = 0; e < 4; ++e) red[w * 1024 + (mt * 16 + fq * 4 + e) * 16 + fr] = acc[mt][e];
    __syncthreads();
    {
        const int o = tid * 2, t = o >> 4;
        float s0 = 0.f, s1 = 0.f;
#pragma unroll
        for (int ww = 0; ww < 8; ++ww) { s0 += red[ww * 1024 + o]; s1 += red[ww * 1024 + o + 1]; }
        const float rs = rstd_of(((const u64*)(ws + WS_SUMSQ))[(size_t)l * T + c * 64 + t]);
        float* zl = (float*)(ws + WS_ZLR) + (size_t)(c * 64) * 16 + o;
        zl[0] = s0 * rs; zl[1] = s1 * rs;
    }
    __syncthreads();
}

__device__ __forceinline__ void gla_sample_state_item(const Params& p, int l, int sidx4, LAS unsigned char* lds) {
    int tid = threadIdx.x; asm volatile("" : "+v"(tid)); asm volatile("" : "+s"(l));
    const int lane = tid & 63, wv = tid >> 6, fr = lane & 15, fq = lane >> 4, d = tid & 127, tg = tid >> 7;
    const int s = sidx4 >> 2, h = sidx4 & 3, tok0 = TP + s * 64;
    unsigned char* ws = p.ws;
    LAS float* gs = (LAS float*)(lds + 8192);
    LAS float* dl = (LAS float*)(lds + 8192 + 2048);
    LAS unsigned char* kt = lds + 16384;
    const u16* kp = (const u16*)(ws + WS_ZK) + (size_t)(tok0 + tg * 16) * 512 + h * 128 + d;
    u16 kr[16];
#pragma unroll
    for (int i = 0; i < 16; ++i) kr[i] = kp[i * 512];
    float b[16], blast;
    gla_gates(p, l, h, tok0, d, tg, gs, b, blast);
#pragma unroll
    for (int i = 0; i < 16; ++i) ((LAS u16*)kt)[d * 72 + tg * 16 + i] = f2bf(bf2f(kr[i]) * __expf(blast - b[i]));
    if (tg == 0) dl[d] = __expf(blast);
    __syncthreads();
    const u16* vt = (const u16*)(ws + WS_ZVT) + (size_t)(h * 256 + wv * 32 + fr) * T + tok0 + fq * 8;
    const size_t so_off = (((size_t)l * 8 + s) * 4 + h) * 32768;
    const float* s0 = p.state_gla + so_off;
    float* so = p.out + OFF_GSS + so_off;
#pragma unroll
    for (int n = 0; n < 2; ++n) {
        const bf16x8 v0 = *(const bf16x8*)(vt + (size_t)(n * 16) * T), v1 = *(const bf16x8*)(vt + (size_t)(n * 16) * T + 32);
        const int dv = wv * 32 + n * 16 + fr;
#pragma unroll
        for (int mt = 0; mt < 8; ++mt) {
            f32x4 a = (f32x4){0.f, 0.f, 0.f, 0.f};
            const bf16x8 k0 = *(const LAS bf16x8*)(kt + (mt * 16 + fr) * 144 + (fq * 8) * 2), k1 = *(const LAS bf16x8*)(kt + (mt * 16 + fr) * 144 + (32 + fq * 8) * 2);
            a = __builtin_amdgcn_mfma_f32_16x16x32_bf16(k0, v0, a, 0, 0, 0);
            a = __builtin_amdgcn_mfma_f32_16x16x32_bf16(k1, v1, a, 0, 0, 0);
            const int dk0 = mt * 16 + fq * 4;
#pragma unroll
            for (int e = 0; e < 4; ++e) so[(dk0 + e) * 256 + dv] = dl[dk0 + e] * s0[(dk0 + e) * 256 + dv] + a[e];
        }
    }
    __syncthreads();
}

__device__ __forceinline__ void gmlp_item(const Params& p, int l, int mc, int g, LAS unsigned char* lds) {
    int tid = threadIdx.x; asm volatile("" : "+v"(tid)); asm volatile("" : "+s"(l));
    const int lane = tid & 63, w = tid >> 6, fr = lane & 15, fq = lane >> 4;
    unsigned char* ws = p.ws;
    LAS float* rsum = (LAS float*)lds;
    LAS float* rsq = (LAS float*)(lds + 2048);
    LAS unsigned char* Vn = lds + 4096;
    LAS float* lnp = (LAS float*)(lds + 4096 + 69632);
    lnp[tid] = (tid < 256) ? p.mlp_ln_g[l * 1024 + g * 256 + tid] : p.mlp_ln_b[l * 1024 + g * 256 + tid - 256];
    const bool smp = mc >= 128;
    const int ntok = smp ? 64 : 128, tok0 = smp ? TP + (mc - 128) * 64 : mc * 128;
    const int tk = tid & 127, cq = tid >> 7; const bool active = tk < ntok;
    const int oct = tid & 15, row0 = tid >> 4; const bool act8 = oct * 8 < ntok;
    LAS float* part = (LAS float*)(lds + 77824);
    LAS float* stat = (LAS float*)(lds + 77824 + 8192);
    LAS unsigned char* Wl = lds + 88064;
    {
        const u16* wsrc = (const u16*)(ws + WS_WSB) + (size_t)(l * 4 + g) * 128 * 128;
        u32x4 wt[4];
#pragma unroll
        for (int i = 0; i < 4; ++i) { const int ch = tid + i * 512; wt[i] = *(const u32x4*)(wsrc + (ch >> 4) * 128 + (ch & 15) * 8); }
#pragma unroll
        for (int i = 0; i < 4; ++i) { const int ch = tid + i * 512; *(LAS u32x4*)(Wl + (ch >> 4) * 272 + (ch & 15) * 16) = wt[i]; }
    }
    u32x4 raw[8];
    {
        const u16* vp = (const u16*)(ws + WS_ZVMT) + (size_t)(g * 256 + row0) * T + tok0 + oct * 8;
#pragma unroll
        for (int i = 0; i < 8; ++i) raw[i] = act8 ? *(const u32x4*)(vp + (size_t)(32 * i) * T) : (u32x4){0u, 0u, 0u, 0u};
    }
    {
        float ps[8], pq[8];
#pragma unroll
        for (int j = 0; j < 8; ++j) { ps[j] = 0.f; pq[j] = 0.f; }
#pragma unroll
        for (int i = 0; i < 8; ++i) {
            const float x0 = bflo(raw[i].x), x1 = bfhi(raw[i].x), x2 = bflo(raw[i].y), x3 = bfhi(raw[i].y), x4 = bflo(raw[i].z), x5 = bfhi(raw[i].z), x6 = bflo(raw[i].w), x7 = bfhi(raw[i].w);
            ps[0] += x0; pq[0] += x0 * x0; ps[1] += x1; pq[1] += x1 * x1; ps[2] += x2; pq[2] += x2 * x2; ps[3] += x3; pq[3] += x3 * x3;
            ps[4] += x4; pq[4] += x4 * x4; ps[5] += x5; pq[5] += x5 * x5; ps[6] += x6; pq[6] += x6 * x6; ps[7] += x7; pq[7] += x7 * x7;
        }
#pragma unroll
        for (int j = 0; j < 8; ++j) { ps[j] += __shfl_xor(ps[j], 16); ps[j] += __shfl_xor(ps[j], 32); pq[j] += __shfl_xor(pq[j], 16); pq[j] += __shfl_xor(pq[j], 32); }
        if (lane < 16) {
#pragma unroll
            for (int j = 0; j < 8; ++j) { part[(w * 128 + oct * 8 + j) * 2] = ps[j]; part[(w * 128 + oct * 8 + j) * 2 + 1] = pq[j]; }
        }
    }
    __syncthreads();
    if (tid < 128) {
        float S = 0.f, S2 = 0.f;
#pragma unroll
        for (int ww = 0; ww < 8; ++ww) { S += part[(ww * 128 + tid) * 2]; S2 += part[(ww * 128 + tid) * 2 + 1]; }
        const float mu = S * (1.f / 256.f), var = fmaxf(S2 * (1.f / 256.f) - mu * mu, 0.f);
        stat[tid * 2] = mu; stat[tid * 2 + 1] = rsqrtf(var + EPS);
    }
    __syncthreads();
    {
        float mu[8], rs[8];
#pragma unroll
        for (int j = 0; j < 8; ++j) { mu[j] = stat[(oct * 8 + j) * 2]; rs[j] = stat[(oct * 8 + j) * 2 + 1]; }
        float* mvs = p.out + OFF_MVS + (((size_t)l * 8 + (mc - 128)) * 64 + oct * 8) * 1024 + g * 256;
#pragma unroll
        for (int i = 0; i < 8; ++i) {
            const int c = row0 + 32 * i; const float gg = lnp[c], bb = lnp[256 + c];
            float vn[8];
            vn[0] = (bflo(raw[i].x) - mu[0]) * rs[0] * gg + bb; vn[1] = (bfhi(raw[i].x) - mu[1]) * rs[1] * gg + bb;
            vn[2] = (bflo(raw[i].y) - mu[2]) * rs[2] * gg + bb; vn[3] = (bfhi(raw[i].y) - mu[3]) * rs[3] * gg + bb;
            vn[4] = (bflo(raw[i].z) - mu[4]) * rs[4] * gg + bb; vn[5] = (bfhi(raw[i].z) - mu[5]) * rs[5] * gg + bb;
            vn[6] = (bflo(raw[i].w) - mu[6]) * rs[6] * gg + bb; vn[7] = (bfhi(raw[i].w) - mu[7]) * rs[7] * gg + bb;
            u32x4 wv = (u32x4){0u, 0u, 0u, 0u};
            if (act8) {
                wv.x = cvt_pk_bf16(vn[0], vn[1]); wv.y = cvt_pk_bf16(vn[2], vn[3]); wv.z = cvt_pk_bf16(vn[4], vn[5]); wv.w = cvt_pk_bf16(vn[6], vn[7]);
                if (smp) {
#pragma unroll
                    for (int j = 0; j < 8; ++j) mvs[(size_t)j * 1024 + c] = vn[j];
                }
            }
            *(LAS u32x4*)(Vn + c * 272 + oct * 16) = wv;
        }
    }
    __syncthreads();
    const int ntt = ntok >> 4;
    f32x4 acc[2][8];
#pragma unroll
    for (int tt = 0; tt < 8; ++tt) { acc[0][tt] = (f32x4){0.f, 0.f, 0.f, 0.f}; acc[1][tt] = (f32x4){0.f, 0.f, 0.f, 0.f}; }
#pragma unroll
    for (int kk = 0; kk < 4; ++kk) {
        bf16x8 a[2];
#pragma unroll
        for (int ct = 0; ct < 2; ++ct) a[ct] = *(const LAS bf16x8*)(Vn + (w * 32 + ct * 16 + fr) * 272 + (kk * 32 + fq * 8) * 2);
#pragma unroll
        for (int tt = 0; tt < 8; ++tt) {
            if ((tt >> 1) >= kk && tt < ntt) {
                const bf16x8 bw = *(const LAS bf16x8*)(Wl + (tt * 16 + fr) * 272 + (kk * 32 + fq * 8) * 2);
#pragma unroll
                for (int ct = 0; ct < 2; ++ct) acc[ct][tt] = __builtin_amdgcn_mfma_f32_16x16x32_bf16(a[ct], bw, acc[ct][tt], 0, 0, 0);
            }
        }
    }
    const float* bsp = p.b_s + (size_t)(l * 4 + g) * 128;
#pragma unroll
    for (int tt = 0; tt < 8; ++tt) {
        if (tt < ntt) {
            const int tok = tok0 + tt * 16 + fr; const float bs = bsp[tt * 16 + fr];
#pragma unroll
            for (int ct = 0; ct < 2; ++ct) {
                const int cb = g * 256 + w * 32 + ct * 16 + fq * 4;
                const u32x2 uu = *(const u32x2*)((const u16*)(ws + WS_ZU) + (size_t)tok * 1024 + cb);
                const u32x2 gg = *(const u32x2*)((const u16*)(ws + WS_ZGB) + (size_t)tok * 1024 + cb);
                const float o0 = bflo(uu.x) * (acc[ct][tt][0] + bs) * silu(bflo(gg.x));
                const float o1 = bfhi(uu.x) * (acc[ct][tt][1] + bs) * silu(bfhi(gg.x));
                const float o2 = bflo(uu.y) * (acc[ct][tt][2] + bs) * silu(bflo(gg.y));
                const float o3 = bfhi(uu.y) * (acc[ct][tt][3] + bs) * silu(bfhi(gg.y));
                u32x2 wv; wv.x = cvt_pk_bf16(o0, o1); wv.y = cvt_pk_bf16(o2, o3);
                *(u32x2*)((u16*)(ws + WS_OBUF) + (size_t)tok * 2048 + 1024 + cb) = wv;
            }
        }
    }
    __syncthreads();
}

__device__ __forceinline__ void phase_final(const Params& p) {
    int tid = threadIdx.x; asm volatile("" : "+v"(tid));
    const int lane = tid & 63, wid = tid >> 6;
    const u16* xb = (const u16*)(p.ws + WS_XB);
    const u64* ss = (const u64*)(p.ws + WS_SUMSQ) + (size_t)4 * T;
    for (int row = blockIdx.x * 8 + wid; row < T; row += gridDim.x * 8) {
        const float rs = rstd_of(ss[row]);
#pragma unroll
        for (int j = 0; j < 4; ++j) {
            const u32x4 xw = *(const u32x4*)(xb + (size_t)row * 2048 + j * 512 + lane * 8);
            const f32x4 g0 = *(const f32x4*)(p.final_norm_g + j * 512 + lane * 8), g1 = *(const f32x4*)(p.final_norm_g + j * 512 + lane * 8 + 4);
            float* o = p.out + OFF_Y + (size_t)row * 2048 + j * 512 + lane * 8;
            *(f32x4*)o = (f32x4){bflo(xw.x), bfhi(xw.x), bflo(xw.y), bfhi(xw.y)} * rs * g0;
            *(f32x4*)(o + 4) = (f32x4){bflo(xw.z), bfhi(xw.z), bflo(xw.w), bfhi(xw.w)} * rs * g1;
        }
    }
}

#define XB_TMO      128
#define XB_XCNT(j)  (256  + 64 * (j))
#define XB_XSUB(j)  (1280 + 64 * (j))
#define XB_XGEN(j)  (2304 + 64 * (j))
#define XB_TOP      3328
#define XB_TOPGEN   3392
#define XB_QUEUE    3520
#define XB_SPIN_CAP (1u << 20)
__device__ __forceinline__ unsigned xb_ld(unsigned* p)              { return __hip_atomic_load(p, __ATOMIC_RELAXED, __HIP_MEMORY_SCOPE_AGENT); }
__device__ __forceinline__ unsigned xb_add(unsigned* p, unsigned v) { return __hip_atomic_fetch_add(p, v, __ATOMIC_RELAXED, __HIP_MEMORY_SCOPE_AGENT); }
__device__ __forceinline__ unsigned xb_xcc_id() { return (unsigned)__builtin_amdgcn_s_getreg((3 << 11) | 20) & 0xFu; }
#define XB_SPIN(cond, bar) do { unsigned _sp = 0; while (cond) { __builtin_amdgcn_s_sleep(1); \
    if ((++_sp & 255u) == 0u) { if (xb_ld(&(bar)[XB_TMO])) break; if (_sp > XB_SPIN_CAP) { atomicAdd(&(bar)[XB_TMO], 1u); break; } } } } while (0)
struct XcdBarrier { unsigned* bar; unsigned x; volatile LAS unsigned* st; };
__device__ __forceinline__ void xcd_barrier_complete(unsigned* bar, unsigned x, unsigned& nloc, unsigned& nx) {
    const unsigned G = gridDim.x;
    unsigned sum, cnt, mine, sp = 0u;
    for (;;) {
        sum = 0u; cnt = 0u; mine = 0u;
#pragma unroll
        for (unsigned j = 0; j < 16; ++j) { const unsigned c = xb_ld(&bar[XB_XCNT(j)]); sum += c; cnt += (c > 0u) ? 1u : 0u; mine = (j == x) ? c : mine; }
        if (sum == G) break;
        __builtin_amdgcn_s_sleep(1);
        if ((++sp & 255u) == 0u) { if (xb_ld(&bar[XB_TMO])) break; if (sp > XB_SPIN_CAP) { atomicAdd(&bar[XB_TMO], 1u); break; } }
    }
    nloc = mine > 0u ? mine : 1u; nx = cnt > 0u ? cnt : 1u;
}
__device__ __forceinline__ void grid_barrier(const XcdBarrier& b) {
    asm volatile("s_waitcnt vmcnt(0)" ::: "memory");
    __syncthreads();
    if (threadIdx.x == 0) {
        unsigned* bar = b.bar;
        __builtin_amdgcn_s_waitcnt(0);
        unsigned nloc = b.st[0], nx = b.st[1];
        if (nloc == 0u) { xcd_barrier_complete(bar, b.x, nloc, nx); b.st[0] = nloc; b.st[1] = nx; }
        const unsigned old = xb_add(&bar[XB_XSUB(b.x)], 1u);
        const unsigned gen = old / nloc;
        if (old + 1u == (gen + 1u) * nloc) {
            __builtin_amdgcn_fence(__ATOMIC_RELEASE, "agent");
            asm volatile("s_waitcnt vmcnt(0)" ::: "memory");
            const unsigned og = xb_add(&bar[XB_TOP], 1u);
            const unsigned tg = og / nx;
            if (og + 1u == (tg + 1u) * nx) xb_add(&bar[XB_TOPGEN], 1u);
            else XB_SPIN(xb_ld(&bar[XB_TOPGEN]) == tg, bar);
            __builtin_amdgcn_fence(__ATOMIC_ACQUIRE, "agent");
            xb_add(&bar[XB_XGEN(b.x)], 1u);
            asm volatile("s_waitcnt vmcnt(0)" ::: "memory");
        } else {
            XB_SPIN(xb_ld(&bar[XB_XGEN(b.x)]) == gen, bar);
            __builtin_amdgcn_fence(__ATOMIC_ACQUIRE, "agent");
            asm volatile("s_waitcnt vmcnt(0)" ::: "memory");
        }
    }
    __syncthreads();
}

__device__ __forceinline__ int queue_next(unsigned* ctr, LAS int* slot) {
    __syncthreads();
    if (threadIdx.x == 0) *slot = (int)__hip_atomic_fetch_add(ctr, 1u, __ATOMIC_RELAXED, __HIP_MEMORY_SCOPE_AGENT);
    __syncthreads();
    return *slot;
}

__global__ void __launch_bounds__(NTHREADS) fwd_megakernel(Params p) {
    extern __shared__ __attribute__((aligned(16))) unsigned char lds_raw[];
    LAS unsigned char* lds = (LAS unsigned char*)lds_raw;
    cg::grid_group grid = cg::this_grid();
    unsigned* bar = (unsigned*)(p.ws + WS_BAR);
    LAS int* qslot = (LAS int*)(lds + 131072);
    XcdBarrier xb; xb.bar = bar; xb.x = xb_xcc_id(); xb.st = (volatile LAS unsigned*)(lds + 131072 + 16);
    if (threadIdx.x == 0) { xb.st[0] = 0u; xb.st[1] = 0u; (void)xb_add(&bar[XB_XCNT(xb.x)], 1u); }
    __syncthreads();
    grid.sync();
    phase_prep(p, lds);
    if (PROBE_DUP & 1) { grid_barrier(xb); phase_prep(p, lds); }
    grid_barrier(xb);
#pragma unroll 1
    for (int l = 0; l < DEPTH; ++l) {
        const int bx = blockIdx.x;
        {
            const int grp = (bx >> 3) & 1;
#pragma unroll 1
            for (int pass = 0; pass < 2; ++pass) {
                if (pass == grp) for (int c = bx; c < 256; c += gridDim.x) lr_item(p, l, c, lds);
                if (pass == 0) gemm_phase<0>(lds, p, l, -1);
            }
        }
        grid_barrier(xb);
#pragma unroll 1
        for (int sub = 0; sub < 2; ++sub) {
            int start, hi, step;
            if (sub == 0) {
                if (bx < 48) gemm_phase<0>(lds, p, l, bx);
                else if (bx >= 240 && bx < 248) lr_item(p, l, 256 + bx - 240, lds);
                hi = 832; step = 208; start = (bx < 48) ? hi : bx - 48;
            } else {
                hi = 1024; step = 256; start = (bx >= 48) ? 832 + bx - 48 : hi;
                asm volatile("s_waitcnt vmcnt(0)" ::: "memory");
                __syncthreads();
                if (threadIdx.x == 0) { __builtin_amdgcn_fence(__ATOMIC_ACQUIRE, "agent"); asm volatile("s_waitcnt vmcnt(0)" ::: "memory"); }
                __syncthreads();
            }
            for (int it = start; it < hi; it += step) gla_local_item(p, l, it >> 2, it & 3, lds);
        }
        grid_barrier(xb);
#pragma unroll 1
        for (int sub = 0; sub < 2; ++sub) {
            unsigned* qc = bar + XB_QUEUE + l * 8 + 2;
#pragma unroll 1
            for (int n = 0;; ++n) {
                int code;
                if (sub == 0) {
                    const int q = queue_next(qc, qslot);
                    if (q >= 496) break;
                    code = (q < 400) ? q : (q < 432 ? 64 + 512 + (q - 400) : (q < 464 ? 608 + (q - 432) : 640 + (q - 464)));
                } else {
                    if (bx < 16) { if (n > 0) break; code = 3000 + bx; }
                    else {
                        const int k = bx - 16;
                        if (n < 4) code = 1000 + k + 240 * n;
                        else if (n == 4) code = (k < 64) ? 1000 + k + 960 : 64 + 336 + (k - 64);
                        else break;
                    }
                }
                if (code < 64) scan_task(p, l, code, lds);
                else if (code < 608) gmlp_item(p, l, (code - 64) >> 2, (code - 64) & 3, lds);
                else if (code < 640) gla_out_item<true>(p, l, 256 + ((code - 608) >> 2), (code - 608) & 3, lds);
                else if (code < 672) gla_sample_state_item(p, l, code - 640, lds);
                else if (code < 3000) gla_out_item<false>(p, l, (code - 1000) >> 2, (code - 1000) & 3, lds);
                else gemm_phase<1>(lds, p, l, code - 3000);
            }
            grid_barrier(xb);
        }
        gemm_phase<1>(lds, p, l, -1);
        grid_barrier(xb);
    }
    phase_final(p);
}

extern "C" void kernel_launch(void* const* d_in, const int* in_sizes, int n_in, void* d_out, int out_size, void* d_ws, size_t ws_size, hipStream_t stream) {
    static int grid = 0;
    if (grid == 0) {
        if (n_in != 14 || ws_size < WS_END) { fprintf(stderr, "kernel_launch: unexpected n_in %d / ws_size %zu (need %zu)\n", n_in, ws_size, (size_t)WS_END); grid = -1; return; }
        int dev = 0, cus = 0, per_cu = 0;
        (void)hipGetDevice(&dev);
        (void)hipDeviceGetAttribute(&cus, hipDeviceAttributeMultiprocessorCount, dev);
        if (hipFuncSetAttribute((const void*)fwd_megakernel, hipFuncAttributeMaxDynamicSharedMemorySize, LDS_BYTES) != hipSuccess) { fprintf(stderr, "kernel_launch: hipFuncSetAttribute failed\n"); grid = -1; return; }
        (void)hipOccupancyMaxActiveBlocksPerMultiprocessor(&per_cu, (const void*)fwd_megakernel, NTHREADS, LDS_BYTES);
        (void)hipGetLastError();
        if (per_cu < 1) { fprintf(stderr, "kernel_launch: occupancy query says %d blocks per CU\n", per_cu); per_cu = 1; }
        grid = cus;
    }
    if (grid < 0) return;
    (void)hipMemsetAsync((unsigned char*)d_ws + WS_BAR, 0, 16384, stream);
    Params p{};
    p.x_prompt = (const float*)d_in[0]; p.x_sample = (const float*)d_in[1]; p.state_gla = (const float*)d_in[2]; p.w_in = (const float*)d_in[3];
    p.w_gate_up = (const float*)d_in[4]; p.b_gate = (const float*)d_in[5]; p.w_s = (const float*)d_in[6]; p.b_s = (const float*)d_in[7];
    p.norm_g = (const float*)d_in[8]; p.gla_norm_g = (const float*)d_in[9]; p.mlp_ln_g = (const float*)d_in[10]; p.mlp_ln_b = (const float*)d_in[11];
    p.w_out = (const float*)d_in[12]; p.final_norm_g = (const float*)d_in[13];
    p.out = (float*)d_out; p.ws = (unsigned char*)d_ws;
    void* args[] = {&p};
    hipError_t e = hipLaunchCooperativeKernel((const void*)fwd_megakernel, dim3(grid), dim3(NTHREADS), args, LDS_BYTES, stream);
    if (e != hipSuccess) fprintf(stderr, "cooperative launch failed: %s (grid %d)\n", hipGetErrorString(e), grid);
}
```

```cpp
#include <hip/hip_runtime.h>
#include <hip/hip_cooperative_groups.h>
#include <cstdio>
#include <cstdint>
namespace cg = cooperative_groups;

#define LAS __attribute__((address_space(3)))
typedef unsigned short u16;
typedef short bf16x8 __attribute__((ext_vector_type(8)));
typedef float f32x4 __attribute__((ext_vector_type(4)));
typedef unsigned u32x4 __attribute__((ext_vector_type(4)));
typedef unsigned u32x2 __attribute__((ext_vector_type(2)));

constexpr int T = 16896, TP = 16384, DM = 2048, DEPTH = 4, DIN = 6160;
constexpr int NZROWS = 6400;
constexpr int NCH = 264;
constexpr int NTHREADS = 512;
#ifndef PROBE_DUP
#define PROBE_DUP 0
#endif
constexpr int LDS_BYTES = 131072 + 256 + 1024;
constexpr float EPS = 1e-6f;
constexpr float SS_SCALE = 1048576.f, SS_INV = 1.f / (1048576.f * 2048.f);
typedef unsigned long long u64;
__device__ __forceinline__ float rstd_of(u64 s) { return rsqrtf((float)s * SS_INV + EPS); }

constexpr size_t AL(size_t x) { return (x + 255) & ~(size_t)255; }
constexpr size_t WS_WTIN = 0;
constexpr size_t WS_WTOUT = WS_WTIN + AL((size_t)DEPTH * NZROWS * 2048 * 2);
constexpr size_t WS_XRES = WS_WTOUT + AL((size_t)DEPTH * 2048 * 2048 * 2);
constexpr size_t WS_XB = WS_XRES + AL((size_t)T * 2048 * 4);
constexpr size_t WS_ZQ = WS_XB + AL((size_t)T * 2048 * 2);
constexpr size_t WS_ZK = WS_ZQ + AL((size_t)T * 512 * 2);
constexpr size_t WS_ZVT = WS_ZK + AL((size_t)T * 512 * 2);
constexpr size_t WS_ZGA = WS_ZVT + AL((size_t)T * 1024 * 2);
constexpr size_t WS_ZU = WS_ZGA + AL((size_t)T * 1024 * 2);
constexpr size_t WS_ZVMT = WS_ZU + AL((size_t)T * 1024 * 2);
constexpr size_t WS_ZGB = WS_ZVMT + AL((size_t)T * 1024 * 2);
constexpr size_t WS_ZLR = WS_ZGB + AL((size_t)T * 1024 * 2);
constexpr size_t WS_UT = WS_ZLR + AL((size_t)T * 16 * 4);
constexpr size_t WS_SP = WS_UT + AL((size_t)NCH * 4 * 32768 * 2);
constexpr size_t WS_DEC = WS_SP + AL((size_t)NCH * 4 * 32768 * 2);
constexpr size_t WS_OBUF = WS_DEC + AL((size_t)NCH * 4 * 128 * 4);
constexpr size_t WS_SUMSQ = WS_OBUF + AL((size_t)T * 2048 * 2);
constexpr size_t WS_BAR = WS_SUMSQ + AL((size_t)5 * T * 8);
constexpr size_t WS_BCUM = WS_BAR + 16384;
constexpr size_t WS_WSB = WS_BCUM + AL((size_t)T * 512 * 4);
constexpr size_t WS_END = WS_WSB + AL((size_t)DEPTH * 4 * 128 * 128 * 2);

constexpr size_t OFF_Y = 0;
constexpr size_t OFF_GSP = (size_t)T * 2048;
constexpr size_t OFF_GSS = OFF_GSP + (size_t)DEPTH * 4 * 32768;
constexpr size_t OFF_MVS = OFF_GSS + (size_t)DEPTH * 8 * 4 * 32768;

struct Params {
    const float *x_prompt, *x_sample, *state_gla, *w_in, *w_gate_up, *b_gate, *w_s, *b_s, *norm_g, *gla_norm_g, *mlp_ln_g, *mlp_ln_b, *w_out, *final_norm_g;
    float* out; unsigned char* ws;
};

__device__ __forceinline__ unsigned cvt_pk_bf16(float lo, float hi) { unsigned r; asm("v_cvt_pk_bf16_f32 %0, %1, %2" : "=v"(r) : "v"(lo), "v"(hi)); return r; }
__device__ __forceinline__ u16 f2bf(float f) { return (u16)(cvt_pk_bf16(f, 0.f) & 0xffffu); }
__device__ __forceinline__ float bf2f(u16 b) { return __uint_as_float(((unsigned)b) << 16); }
__device__ __forceinline__ float bflo(unsigned w) { return __uint_as_float(w << 16); }
__device__ __forceinline__ float bfhi(unsigned w) { return __uint_as_float(w & 0xffff0000u); }
__device__ __forceinline__ float silu(float x) { return x / (1.f + __expf(-x)); }

__device__ __forceinline__ void phase_prep(const Params& p, LAS unsigned char* lds) {
    int tid = threadIdx.x; asm volatile("" : "+v"(tid));
    const int lane = tid & 63, wid = tid >> 6;
    unsigned char* ws = p.ws;
    u64* sumsq = (u64*)(ws + WS_SUMSQ);
    for (int i = blockIdx.x * NTHREADS + tid; i < 4 * T; i += gridDim.x * NTHREADS) sumsq[T + i] = 0ull;
    u16* xb = (u16*)(ws + WS_XB);
    for (int row = blockIdx.x * 8 + wid; row < T; row += gridDim.x * 16) {
        const int row2 = row + gridDim.x * 8; const bool has2 = row2 < T;
        const float* xr = row < TP ? p.x_prompt + (size_t)row * 2048 : p.x_sample + (size_t)(row - TP) * 2048;
        const float* xr2 = has2 ? (row2 < TP ? p.x_prompt + (size_t)row2 * 2048 : p.x_sample + (size_t)(row2 - TP) * 2048) : xr;
        f32x4 va[8], vb[8];
#pragma unroll
        for (int j = 0; j < 8; ++j) { va[j] = *(const f32x4*)(xr + j * 256 + lane * 4); vb[j] = *(const f32x4*)(xr2 + j * 256 + lane * 4); }
        float ss = 0.f, ss2 = 0.f;
#pragma unroll
        for (int j = 0; j < 8; ++j) {
            ss += va[j][0] * va[j][0] + va[j][1] * va[j][1] + va[j][2] * va[j][2] + va[j][3] * va[j][3];
            ss2 += vb[j][0] * vb[j][0] + vb[j][1] * vb[j][1] + vb[j][2] * vb[j][2] + vb[j][3] * vb[j][3];
            u32x2 w; w.x = cvt_pk_bf16(va[j][0], va[j][1]); w.y = cvt_pk_bf16(va[j][2], va[j][3]);
            *(u32x2*)(xb + (size_t)row * 2048 + j * 256 + lane * 4) = w;
            if (has2) { u32x2 w2; w2.x = cvt_pk_bf16(vb[j][0], vb[j][1]); w2.y = cvt_pk_bf16(vb[j][2], vb[j][3]);
                *(u32x2*)(xb + (size_t)row2 * 2048 + j * 256 + lane * 4) = w2; }
        }
#pragma unroll
        for (int o = 32; o >= 1; o >>= 1) { ss += __shfl_xor(ss, o); ss2 += __shfl_xor(ss2, o); }
        if (lane == 0) { sumsq[row] = (u64)(ss * SS_SCALE); if (has2) sumsq[row2] = (u64)(ss2 * SS_SCALE); }
    }
    for (int e = blockIdx.x * NTHREADS + tid; e < DEPTH * 2048 * 16; e += gridDim.x * NTHREADS) {
        const int l = e / (2048 * 16), r = e % (2048 * 16), k = r >> 4, n = r & 15;
        const float v = p.w_in[((size_t)l * 2048 + k) * DIN + 3072 + n] * p.norm_g[l * 2048 + k];
        ((u16*)(ws + WS_WTIN))[((size_t)l * NZROWS + 6144 + n) * 2048 + k] = f2bf(v);
    }
    for (int e = blockIdx.x * NTHREADS + tid; e < DEPTH * 4 * 128 * 128; e += gridDim.x * NTHREADS) {
        const int t = (e >> 7) & 127, s = e & 127;
        ((u16*)(ws + WS_WSB))[e] = f2bf(s <= t ? p.w_s[e] : 0.f);
    }
    LAS float* tile = (LAS float*)lds;
#define PREP_DECODE(job, src, dst, ldsrc, k0, n0, srccol0, g) do { const int _l = (job) >> 10; int _r = (job) & 1023; int _kt, _nb; \
        if (_r < 768) { _kt = _r / 24; _nb = _r % 24; src = p.w_in + (size_t)_l * 2048 * DIN; ldsrc = DIN; srccol0 = _nb * 256 + (_nb >= 12 ? 16 : 0); \
            dst = (u16*)(ws + WS_WTIN) + (size_t)_l * NZROWS * 2048; g = p.norm_g + _l * 2048; } \
        else { _r -= 768; _kt = _r >> 3; _nb = _r & 7; src = p.w_out + (size_t)_l * 2048 * 2048; ldsrc = 2048; srccol0 = _nb * 256; \
            dst = (u16*)(ws + WS_WTOUT) + (size_t)_l * 2048 * 2048; g = nullptr; } \
        k0 = _kt * 64; n0 = _nb * 256; } while (0)
#define PREP_LOAD(job) do { const float* _src; u16* _dst; int _ld, _k0, _n0, _sc; const float* _g; PREP_DECODE(job, _src, _dst, _ld, _k0, _n0, _sc, _g); (void)_dst; (void)_n0; \
        _Pragma("unroll") for (int i = 0; i < 8; ++i) { const int e = tid + i * 512, rr = e >> 6, c4 = (e & 63) * 4; \
            v[i] = *(const f32x4*)(_src + (size_t)(_k0 + rr) * _ld + _sc + c4); gv[i] = _g ? _g[_k0 + rr] : 1.f; } } while (0)
    {
        f32x4 v[8]; float gv[8];
        int job = blockIdx.x;
        if (job < DEPTH * 1024) PREP_LOAD(job);
        for (; job < DEPTH * 1024; job += gridDim.x) {
            const float* src; u16* dst; int ldsrc, k0, n0, srccol0; const float* g;
            PREP_DECODE(job, src, dst, ldsrc, k0, n0, srccol0, g); (void)src; (void)ldsrc; (void)srccol0; (void)g;
#pragma unroll
            for (int i = 0; i < 8; ++i) { const int e = tid + i * 512, rr = e >> 6, c4 = (e & 63) * 4;
#pragma unroll
                for (int j = 0; j < 4; ++j) tile[rr * 257 + c4 + j] = v[i][j] * gv[i]; }
            const int nextjob = job + gridDim.x;
            if (nextjob < DEPTH * 1024) PREP_LOAD(nextjob);
            __syncthreads();
#pragma unroll
            for (int i = 0; i < 4; ++i) { const int e = tid + i * 512, n = e >> 3, ko = (e & 7) * 8;
                u32x4 wv;
                wv.x = cvt_pk_bf16(tile[(ko + 0) * 257 + n], tile[(ko + 1) * 257 + n]); wv.y = cvt_pk_bf16(tile[(ko + 2) * 257 + n], tile[(ko + 3) * 257 + n]);
                wv.z = cvt_pk_bf16(tile[(ko + 4) * 257 + n], tile[(ko + 5) * 257 + n]); wv.w = cvt_pk_bf16(tile[(ko + 6) * 257 + n], tile[(ko + 7) * 257 + n]);
                *(u32x4*)(dst + (size_t)(n0 + n) * 2048 + k0 + ko) = wv; }
            __syncthreads();
        }
    }
#undef PREP_DECODE
#undef PREP_LOAD
}

constexpr int BM = 256, BK = 64, HALF = 128, HTB = HALF * BK * 2, NXCD = 8, WGM = 8;
__device__ __forceinline__ int lds_byte(int r, int c) { const int st = (r >> 4) * 2 + (c >> 5), rr = r & 15, cc = c & 31, ob = rr * 64 + cc * 2; return st * 1024 + (ob ^ (((ob >> 9) & 1) << 5)); }
__device__ __forceinline__ void stage_rc(int b, int& R, int& C) { const int st = b / 1024, sb = b % 1024, swz = sb ^ (((sb >> 9) & 1) << 5); R = (st >> 1) * 16 + swz / 64; C = (st & 1) * 32 + (swz % 64) / 2; }
__device__ __forceinline__ int perm32(int rho) { const int n = rho >> 4, i = rho & 15; return 8 * (i >> 2) + 4 * n + (i & 3); }
struct Unit { int pm, pn; };
__device__ __forceinline__ bool unit_next(int i, int G, int c, int nM, int nN, Unit& u) {
    const int nwg = nM * nN; const long L = (long)i * G + c; if (L >= nwg) return false;
    int wgid = (int)L; { const int q = nwg / NXCD, r = nwg % NXCD, xcd = wgid % NXCD, off = wgid / NXCD; wgid = (xcd < r ? xcd * (q + 1) : r * (q + 1) + (xcd - r) * q) + off; }
    const int nig = WGM * nN, gid = wgid / nig, fm = gid * WGM, gsz = (nM - fm) < WGM ? (nM - fm) : WGM;
    u.pm = fm + ((wgid % nig) % gsz); u.pn = (wgid % nig) / gsz; return true;
}
template <int MODE> __device__ __forceinline__ bool unit_swapped(const Unit& u) { return MODE == 0 && ((u.pn >= 4 && u.pn < 8) || (u.pn >= 16 && u.pn < 20)); }
template <int MODE> __device__ __forceinline__ void unit_ptrs(const char* act, const char* wt, const Unit& u, const char*& a, const char*& b) {
    const size_t tstep = (size_t)256 * 2048 * 2;
    const char* pa = act + (size_t)u.pm * tstep; const char* pb = wt + (size_t)u.pn * tstep;
    const bool sw = unit_swapped<MODE>(u);
    a = sw ? pb : pa; b = sw ? pa : pb;
}

template <int MODE>
__device__ __forceinline__ void gemm_epilogue(const Params& p, int l, const f32x4 (&acc)[2][2][4][2], const Unit& u, int wr, int wc, int fr, int fq, const LAS float* rl, int pm0) {
    unsigned char* ws = p.ws;
    const __amdgpu_buffer_rsrc_t wsr = __builtin_amdgcn_make_buffer_rsrc((void*)ws, (short)0, (int)WS_END, 0x00020000);
#define WT_STORE16(ptr, val) __builtin_amdgcn_raw_buffer_store_b128((val), wsr, (int)((const char*)(ptr) - (const char*)ws), 0, 16)
    if (MODE == 0) {
        const u64* ss = (const u64*)(ws + WS_SUMSQ) + (size_t)l * T;
        if (!unit_swapped<0>(u)) {
            const int pn = u.pn;
            u16* ob; int ld;
            if (pn < 2) { ob = (u16*)(ws + WS_ZQ) + pn * 256; ld = 512; }
            else if (pn < 4) { ob = (u16*)(ws + WS_ZK) + (pn - 2) * 256; ld = 512; }
            else if (pn < 12) { ob = (u16*)(ws + WS_ZGA) + (pn - 8) * 256; ld = 1024; }
            else if (pn < 16) { ob = (u16*)(ws + WS_ZU) + (pn - 12) * 256; ld = 1024; }
            else { ob = (u16*)(ws + WS_ZGB) + (pn - 20) * 256; ld = 1024; }
#pragma unroll
            for (int ai = 0; ai < 2; ++ai)
#pragma unroll
                for (int m = 0; m < 4; ++m) {
                    const int tok = u.pm * 256 + 128 * ai + 64 * wr + 16 * m + fr;
                    const float rs = (u.pm == pm0) ? rl[128 * ai + 64 * wr + 16 * m + fr] : rstd_of(ss[tok]);
#pragma unroll
                    for (int bj = 0; bj < 2; ++bj) {
                        const f32x4 v0 = acc[ai][bj][m][0] * rs, v1 = acc[ai][bj][m][1] * rs;
                        u32x4 w; w.x = cvt_pk_bf16(v0[0], v0[1]); w.y = cvt_pk_bf16(v0[2], v0[3]); w.z = cvt_pk_bf16(v1[0], v1[1]); w.w = cvt_pk_bf16(v1[2], v1[3]);
                        WT_STORE16(ob + (size_t)tok * ld + 128 * bj + 32 * wc + 8 * fq, w);
                    }
                }
        } else {
            u16* ob = (u.pn < 8) ? (u16*)(ws + WS_ZVT) + (size_t)((u.pn - 4) * 256) * T : (u16*)(ws + WS_ZVMT) + (size_t)((u.pn - 16) * 256) * T;
#pragma unroll
            for (int bj = 0; bj < 2; ++bj) {
                const int tok0 = u.pm * 256 + 128 * bj + 32 * wc + 8 * fq;
                f32x4 s0, s1;
#pragma unroll
                for (int e = 0; e < 4; ++e) { s0[e] = (u.pm == pm0) ? rl[128 * bj + 32 * wc + 8 * fq + e] : rstd_of(ss[tok0 + e]); s1[e] = (u.pm == pm0) ? rl[128 * bj + 32 * wc + 8 * fq + 4 + e] : rstd_of(ss[tok0 + 4 + e]); }
#pragma unroll
                for (int ai = 0; ai < 2; ++ai)
#pragma unroll
                    for (int m = 0; m < 4; ++m) {
                        const int zr = 128 * ai + 64 * wr + 16 * m + fr;
                        const f32x4 v0 = acc[ai][bj][m][0] * s0, v1 = acc[ai][bj][m][1] * s1;
                        u32x4 w; w.x = cvt_pk_bf16(v0[0], v0[1]); w.y = cvt_pk_bf16(v0[2], v0[3]); w.z = cvt_pk_bf16(v1[0], v1[1]); w.w = cvt_pk_bf16(v1[2], v1[3]);
                        WT_STORE16(ob + (size_t)zr * T + tok0, w);
                    }
            }
        }
    } else {
        u16* xb = (u16*)(ws + WS_XB);
        u64* ssn = (u64*)(ws + WS_SUMSQ) + (size_t)(l + 1) * T;
#pragma unroll
        for (int ai = 0; ai < 2; ++ai)
#pragma unroll
            for (int m = 0; m < 4; ++m) {
                const int tok = u.pm * 256 + 128 * ai + 64 * wr + 16 * m + fr;
                float part = 0.f;
#pragma unroll
                for (int bj = 0; bj < 2; ++bj) {
                    const size_t idx = (size_t)tok * 2048 + u.pn * 256 + 128 * bj + 32 * wc + 8 * fq;
                    const u32x4 xw = *(const u32x4*)(xb + idx);
                    f32x4 y0 = (f32x4){bflo(xw.x), bfhi(xw.x), bflo(xw.y), bfhi(xw.y)}, y1 = (f32x4){bflo(xw.z), bfhi(xw.z), bflo(xw.w), bfhi(xw.w)};
                    y0 += acc[ai][bj][m][0]; y1 += acc[ai][bj][m][1];
                    part += y0[0] * y0[0] + y0[1] * y0[1] + y0[2] * y0[2] + y0[3] * y0[3] + y1[0] * y1[0] + y1[1] * y1[1] + y1[2] * y1[2] + y1[3] * y1[3];
                    u32x4 w; w.x = cvt_pk_bf16(y0[0], y0[1]); w.y = cvt_pk_bf16(y0[2], y0[3]); w.z = cvt_pk_bf16(y1[0], y1[1]); w.w = cvt_pk_bf16(y1[2], y1[3]);
                    WT_STORE16(xb + idx, w);
                }
                part += __shfl_xor(part, 16); part += __shfl_xor(part, 32);
                if (fq == 0) atomicAdd(ssn + tok, (u64)(part * SS_SCALE));
            }
    }
}

#undef WT_STORE16
template <int MODE>
__device__ __forceinline__ void gemm_phase(LAS unsigned char* lds, const Params& p, int l, int single) {
    int tid = threadIdx.x; asm volatile("" : "+v"(tid)); asm volatile("" : "+s"(l));
    const int wid = __builtin_amdgcn_readfirstlane(tid >> 6), lane = tid & 63, wr = wid >> 2, wc = wid & 3, fr = lane & 15, fq = lane >> 4;
    constexpr int K = 2048, nt = K / BK;
    const int nM = TP / 256, nN = (MODE == 0) ? 24 : 8, G = gridDim.x, cidx = blockIdx.x;
    const char* act = (MODE == 0) ? (const char*)(p.ws + WS_XB) : (const char*)(p.ws + WS_OBUF);
    const char* wt = (MODE == 0) ? (const char*)(p.ws + WS_WTIN) + (size_t)l * NZROWS * 2048 * 2 : (const char*)(p.ws + WS_WTOUT) + (size_t)l * 2048 * 2048 * 2;
    unsigned voffA[2], voffB[2];
#pragma unroll
    for (int i = 0; i < 2; ++i) { int R, C; stage_rc(tid * 16 + i * 8192, R, C); const int Rb = (R & ~31) + perm32(R & 31);
        voffA[i] = (unsigned)(R * K + C) * 2u; voffB[i] = (unsigned)(Rb * K + C) * 2u; }
    const size_t kstep = (size_t)(BK * 2);
    const size_t hstep = (size_t)HALF * K * 2;
    const unsigned ldsw = (unsigned)wid * 1024u;
    const int aoff = lds_byte(wr * 64 + fr, fq * 8), boff = lds_byte(wc * 32 + fr, fq * 8);
#define PG8_SA(b, h) (((b) * 2 + (h)) * HTB)
#define PG8_SB(b, h) ((4 + (b) * 2 + (h)) * HTB)
#define PG8_STAGE(bufoff, gbase, voff) do { _Pragma("unroll") for (int _i = 0; _i < 2; ++_i) \
        __builtin_amdgcn_global_load_lds((const unsigned*)((const char*)(gbase) + (voff)[_i]), (LAS unsigned*)(lds + (bufoff) + ldsw + _i * 8192), 16, 0, 0); } while (0)
#define PG8_LDA(dst, b, h) do { _Pragma("unroll") for (int m = 0; m < 4; ++m) _Pragma("unroll") for (int k = 0; k < 2; ++k) dst[m][k] = *(const LAS bf16x8*)(lds + PG8_SA(b, h) + aoff + m * 2048 + k * 1024); } while (0)
#define PG8_LDB(dst, b, h) do { _Pragma("unroll") for (int n = 0; n < 2; ++n) _Pragma("unroll") for (int k = 0; k < 2; ++k) dst[n][k] = *(const LAS bf16x8*)(lds + PG8_SB(b, h) + boff + n * 2048 + k * 1024); } while (0)
#define PG8_MMA(ai, bj, At, Bt) do { __builtin_amdgcn_s_setprio(1); _Pragma("unroll") for (int m = 0; m < 4; ++m) _Pragma("unroll") for (int n = 0; n < 2; ++n) _Pragma("unroll") for (int k = 0; k < 2; ++k) \
        acc[ai][bj][m][n] = __builtin_amdgcn_mfma_f32_16x16x32_bf16(Bt[n][k], At[m][k], acc[ai][bj][m][n], 0, 0, 0); __builtin_amdgcn_s_setprio(0); } while (0)
#define PG8_WAIT_V(n) asm volatile("s_waitcnt vmcnt(" #n ")" ::: "memory")
#define PG8_WAIT_L(n) asm volatile("s_waitcnt lgkmcnt(" #n ")" ::: "memory")
#define PG8_BAR __builtin_amdgcn_s_barrier()
#define PG8_SCHED __builtin_amdgcn_sched_barrier(0)
    Unit cur, nxt; int ui = 0;
    if (single >= 0) { cur.pm = nM + single / nN; cur.pn = single % nN; }
    else if (!unit_next(0, G, cidx, nM, nN, cur)) return;
    LAS float* rl = (LAS float*)(lds + 131072 + 256);
    const int pm0 = cur.pm;
    if (MODE == 0) {
        if (tid < 256) rl[tid] = rstd_of(((const u64*)(p.ws + WS_SUMSQ))[(size_t)l * T + pm0 * 256 + tid]);
        __syncthreads();
    }
    f32x4 acc[2][2][4][2];
#pragma unroll
    for (int a = 0; a < 2; ++a)
#pragma unroll
        for (int b = 0; b < 2; ++b)
#pragma unroll
            for (int m = 0; m < 4; ++m)
#pragma unroll
                for (int n = 0; n < 2; ++n) acc[a][b][m][n] = (f32x4){0.f, 0.f, 0.f, 0.f};
    bf16x8 At[4][2], B0[2][2], B1[2][2];
    const char *cA, *cB; unit_ptrs<MODE>(act, wt, cur, cA, cB);
    PG8_STAGE(PG8_SB(0, 0), cB, voffB); PG8_STAGE(PG8_SA(0, 0), cA, voffA); PG8_STAGE(PG8_SB(0, 1), cB + hstep, voffB); PG8_STAGE(PG8_SA(0, 1), cA + hstep, voffA);
    if (wr == 1) PG8_BAR;
    PG8_WAIT_V(4); PG8_BAR;
    PG8_STAGE(PG8_SB(1, 0), cB + kstep, voffB); PG8_STAGE(PG8_SA(1, 0), cA + kstep, voffA); PG8_STAGE(PG8_SB(1, 1), cB + hstep + kstep, voffB);
    PG8_WAIT_V(6); PG8_BAR;
    for (;;) {
        const bool has_next = (single < 0) && unit_next(ui + 1, G, cidx, nM, nN, nxt);
        const char *nA = cA, *nB = cB;
        if (has_next) unit_ptrs<MODE>(act, wt, nxt, nA, nB);
        for (int t = 0; t < nt; t += 2) {
            const bool last = (t == nt - 2);
            const char* a1 = cA + (size_t)(t + 1) * kstep;
            const char* a2 = last ? nA : cA + (size_t)(t + 2) * kstep; const char* b2 = last ? nB : cB + (size_t)(t + 2) * kstep;
            const char* a3 = a2 + kstep; const char* b3 = b2 + kstep;
            PG8_LDB(B0, 0, 0); PG8_SCHED; PG8_LDA(At, 0, 0); PG8_STAGE(PG8_SA(1, 1), a1 + hstep, voffA);
            PG8_WAIT_L(8); PG8_BAR; PG8_WAIT_L(0); PG8_MMA(0, 0, At, B0); PG8_BAR; PG8_SCHED;
            PG8_LDB(B1, 0, 1); PG8_STAGE(PG8_SB(0, 0), b2, voffB);
            PG8_BAR; PG8_WAIT_L(0); PG8_MMA(0, 1, At, B1); PG8_BAR;
            PG8_LDA(At, 0, 1); PG8_STAGE(PG8_SA(0, 0), a2, voffA);
            PG8_BAR; PG8_WAIT_L(0); PG8_MMA(1, 0, At, B0); PG8_BAR; PG8_SCHED;
            PG8_STAGE(PG8_SB(0, 1), b2 + hstep, voffB);
            PG8_WAIT_V(6); PG8_BAR; PG8_MMA(1, 1, At, B1); PG8_BAR;
            PG8_LDB(B0, 1, 0); PG8_SCHED; PG8_LDA(At, 1, 0); PG8_STAGE(PG8_SA(0, 1), a2 + hstep, voffA);
            PG8_WAIT_L(8); PG8_BAR; PG8_WAIT_L(0); PG8_MMA(0, 0, At, B0); PG8_BAR; PG8_SCHED;
            PG8_LDB(B1, 1, 1); PG8_STAGE(PG8_SB(1, 0), b3, voffB);
            PG8_BAR; PG8_WAIT_L(0); PG8_MMA(0, 1, At, B1); PG8_BAR;
            PG8_LDA(At, 1, 1); PG8_STAGE(PG8_SA(1, 0), a3, voffA);
            PG8_BAR; PG8_WAIT_L(0); PG8_MMA(1, 0, At, B0); PG8_BAR; PG8_SCHED;
            PG8_STAGE(PG8_SB(1, 1), b3 + hstep, voffB);
            PG8_WAIT_V(6); PG8_BAR; PG8_MMA(1, 1, At, B1); PG8_BAR;
        }
        gemm_epilogue<MODE>(p, l, acc, cur, wr, wc, fr, fq, rl, pm0);
        if (!has_next) break;
#pragma unroll
        for (int a = 0; a < 2; ++a)
#pragma unroll
            for (int b = 0; b < 2; ++b)
#pragma unroll
                for (int m = 0; m < 4; ++m)
#pragma unroll
                    for (int n = 0; n < 2; ++n) acc[a][b][m][n] = (f32x4){0.f, 0.f, 0.f, 0.f};
        cur = nxt; cA = nA; cB = nB; ++ui;
    }
    PG8_WAIT_V(0);
    if (wr == 0) PG8_BAR;
    PG8_BAR;
#undef PG8_SA
#undef PG8_SB
#undef PG8_STAGE
#undef PG8_LDA
#undef PG8_LDB
#undef PG8_MMA
#undef PG8_WAIT_V
#undef PG8_WAIT_L
#undef PG8_BAR
#undef PG8_SCHED
}

__device__ __forceinline__ void gla_gates(const Params& p, int l, int h, int tok0, int d, int tg, LAS float* gsum, float (&b)[16], float& blast) {
    LAS float* lrs = gsum + 25088;
    {
        const int t2 = threadIdx.x;
        if (t2 < 256) *(LAS f32x4*)(lrs + t2 * 4) = *(const f32x4*)((const float*)(p.ws + WS_ZLR) + (size_t)tok0 * 16 + t2 * 4);
    }
    const float* wg = p.w_gate_up + (size_t)l * 16 * 512 + h * 128 + d;
    float w[16];
#pragma unroll
    for (int r = 0; r < 16; ++r) w[r] = wg[r * 512];
    const float bg = p.b_gate[l * 512 + h * 128 + d];
    __syncthreads();
    const LAS float* lr = lrs + (tg * 16) * 16;
    float run = 0.f;
#pragma unroll
    for (int i = 0; i < 16; ++i) {
        float x = bg;
#pragma unroll
        for (int r4 = 0; r4 < 4; ++r4) { const f32x4 a = *(const LAS f32x4*)(lr + i * 16 + r4 * 4);
            x += a[0] * w[r4 * 4] + a[1] * w[r4 * 4 + 1] + a[2] * w[r4 * 4 + 2] + a[3] * w[r4 * 4 + 3]; }
        const float ls = fminf(x, 0.f) - __logf(1.f + __expf(-fabsf(x)));
        run += ls * (1.f / 16.f); b[i] = run;
    }
    gsum[tg * 128 + d] = run;
    __syncthreads();
    float off = 0.f, tot = 0.f;
#pragma unroll
    for (int g = 0; g < 4; ++g) { const float v = gsum[g * 128 + d]; tot += v; if (g < tg) off += v; }
#pragma unroll
    for (int i = 0; i < 16; ++i) b[i] += off;
    blast = tot;
}

__device__ __forceinline__ void gla_local_item(const Params& p, int l, int c, int h, LAS unsigned char* lds) {
    int tid = threadIdx.x; asm volatile("" : "+v"(tid)); asm volatile("" : "+s"(l));
    const int lane = tid & 63, w = tid >> 6, fr = lane & 15, fq = lane >> 4, d = tid & 127, tg = tid >> 7;
    unsigned char* ws = p.ws;
    LAS float* gsum = (LAS float*)lds;
    LAS float* decl = (LAS float*)(lds + 2048);
    LAS unsigned char* kT = lds + 4096;
    const int tok0 = c * 64;
    const u16* kp = (const u16*)(ws + WS_ZK) + (size_t)(tok0 + tg * 16) * 512 + h * 128 + d;
    u16 kraw[16];
#pragma unroll
    for (int i = 0; i < 16; ++i) kraw[i] = kp[i * 512];
    const u16* vt = (const u16*)(ws + WS_ZVT) + (size_t)(h * 256 + w * 32 + fr) * T + tok0 + fq * 8;
    bf16x8 bv[2][2];
#pragma unroll
    for (int kk = 0; kk < 2; ++kk)
#pragma unroll
        for (int n = 0; n < 2; ++n) bv[kk][n] = *(const bf16x8*)(vt + (size_t)(n * 16) * T + kk * 32);
    float b[16], blast;
    gla_gates(p, l, h, tok0, d, tg, gsum, b, blast);
    {
        unsigned* bc = (unsigned*)((u16*)(ws + WS_BCUM) + (size_t)(tok0 + tg * 16) * 512 + h * 128 + (d & ~1));
#pragma unroll
        for (int i = 0; i < 16; ++i) {
            const float ev = __expf(b[i]);
            const float eo = __shfl_down(ev, 1);
            if ((d & 1) == 0) bc[i * 256] = cvt_pk_bf16(ev, eo);
        }
        unsigned pk[8];
#pragma unroll
        for (int i = 0; i < 8; ++i) {
            const float k0 = bf2f(kraw[2 * i]) * __expf(blast - b[2 * i]);
            const float k1 = bf2f(kraw[2 * i + 1]) * __expf(blast - b[2 * i + 1]);
            pk[i] = cvt_pk_bf16(k0, k1);
        }
        u32x4 w0, w1; w0.x = pk[0]; w0.y = pk[1]; w0.z = pk[2]; w0.w = pk[3]; w1.x = pk[4]; w1.y = pk[5]; w1.z = pk[6]; w1.w = pk[7];
        *(LAS u32x4*)(kT + d * 144 + tg * 32) = w0; *(LAS u32x4*)(kT + d * 144 + tg * 32 + 16) = w1;
        if (tg == 0) { const float dc = __expf(blast); decl[d] = dc; ((float*)(ws + WS_DEC))[(size_t)(c * 4 + h) * 128 + d] = dc; }
    }
    __syncthreads();
    f32x4 acc[8][2];
#pragma unroll
    for (int mt = 0; mt < 8; ++mt) { acc[mt][0] = (f32x4){0.f, 0.f, 0.f, 0.f}; acc[mt][1] = (f32x4){0.f, 0.f, 0.f, 0.f}; }
#pragma unroll
    for (int kk = 0; kk < 2; ++kk) {
#pragma unroll
        for (int mt = 0; mt < 8; ++mt) {
            const bf16x8 a = *(const LAS bf16x8*)(kT + (mt * 16 + fr) * 144 + (kk * 32 + fq * 8) * 2);
#pragma unroll
            for (int n = 0; n < 2; ++n) acc[mt][n] = __builtin_amdgcn_mfma_f32_16x16x32_bf16(a, bv[kk][n], acc[mt][n], 0, 0, 0);
        }
    }
    if (c < 256) {
        u16* ut = (u16*)(ws + WS_UT) + (size_t)(c * 4 + h) * 32768;
#pragma unroll
        for (int mt = 0; mt < 8; ++mt)
#pragma unroll
            for (int n = 0; n < 2; ++n) {
                u32x2 wv; wv.x = cvt_pk_bf16(acc[mt][n][0], acc[mt][n][1]); wv.y = cvt_pk_bf16(acc[mt][n][2], acc[mt][n][3]);
                *(u32x2*)(ut + (w * 32 + n * 16 + fr) * 128 + mt * 16 + fq * 4) = wv;
            }
    } else {
        const int s = c - 256;
        const size_t sidx = (((size_t)l * 8 + s) * 4 + h) * 32768;
        const float* s0 = p.state_gla + sidx;
        float* so = p.out + OFF_GSS + sidx;
        u16* sp = (u16*)(ws + WS_SP) + (size_t)(c * 4 + h) * 32768;
#pragma unroll
        for (int mt = 0; mt < 8; ++mt)
#pragma unroll
            for (int n = 0; n < 2; ++n) {
                const int dv = w * 32 + n * 16 + fr, dk0 = mt * 16 + fq * 4;
                float sv[4];
#pragma unroll
                for (int e = 0; e < 4; ++e) { sv[e] = s0[(dk0 + e) * 256 + dv]; so[(dk0 + e) * 256 + dv] = decl[dk0 + e] * sv[e] + acc[mt][n][e]; }
                u32x2 wv; wv.x = cvt_pk_bf16(sv[0], sv[1]); wv.y = cvt_pk_bf16(sv[2], sv[3]);
                *(u32x2*)(sp + dv * 128 + dk0) = wv;
            }
    }
    __syncthreads();
}

__device__ __forceinline__ void scan_task(const Params& p, int l, int j, LAS unsigned char* lds) {
    unsigned char* ws = p.ws;
    int tid = threadIdx.x; asm volatile("" : "+v"(tid)); asm volatile("" : "+s"(l));
    const int e = j * 2048 + tid * 4;
    const int h = e >> 15, dk = e & 127, dv = (e >> 7) & 255;
    const u16* ut = (const u16*)(ws + WS_UT) + e; u16* sp = (u16*)(ws + WS_SP) + e;
    LAS float* dl = (LAS float*)lds;
    {
        const float* dsrc = (const float*)(ws + WS_DEC) + h * 128;
#pragma unroll
        for (int i = 0; i < 16; ++i) { const int q = tid + i * 512, c = q >> 5, d4 = (q & 31) * 4; *(LAS f32x4*)(dl + c * 128 + d4) = *(const f32x4*)(dsrc + (size_t)c * 512 + d4); }
    }
    f32x4 S = (f32x4){0.f, 0.f, 0.f, 0.f};
    u32x2 uvA[16], uvB[16];
#define SCAN_LOAD(uv, cb) do { _Pragma("unroll") for (int i = 0; i < 16; ++i) uv[i] = *(const u32x2*)(ut + (size_t)((cb) + i) * 131072); } while (0)
#define SCAN_STEP(uv, cb) do { _Pragma("unroll") for (int i = 0; i < 16; ++i) { \
            const f32x4 dd = *(const LAS f32x4*)(dl + ((cb) + i) * 128 + dk); \
            u32x2 wv; wv.x = cvt_pk_bf16(S[0], S[1]); wv.y = cvt_pk_bf16(S[2], S[3]); \
            *(u32x2*)(sp + (size_t)((cb) + i) * 131072) = wv; \
            S[0] = dd[0] * S[0] + bflo(uv[i].x); S[1] = dd[1] * S[1] + bfhi(uv[i].x); \
            S[2] = dd[2] * S[2] + bflo(uv[i].y); S[3] = dd[3] * S[3] + bfhi(uv[i].y); } } while (0)
    SCAN_LOAD(uvA, 0);
    __syncthreads();
    for (int c0 = 0; c0 < 256; c0 += 32) {
        SCAN_LOAD(uvB, c0 + 16);
        SCAN_STEP(uvA, c0);
        if (c0 + 32 < 256) SCAN_LOAD(uvA, c0 + 32);
        SCAN_STEP(uvB, c0 + 16);
    }
#undef SCAN_LOAD
#undef SCAN_STEP
    float* go = p.out + OFF_GSP + ((size_t)l * 4 + h) * 32768 + dk * 256 + dv;
#pragma unroll
    for (int i = 0; i < 4; ++i) go[i * 256] = S[i];
}

template <bool SMP>
__device__ __forceinline__ void gla_out_item(const Params& p, int l, int c, int h, LAS unsigned char* lds) {
    int tid = threadIdx.x; asm volatile("" : "+v"(tid)); asm volatile("" : "+s"(l));
    const int lane = tid & 63, w = tid >> 6, fr = lane & 15, fq = lane >> 4, d = tid & 127, tg = tid >> 7;
    unsigned char* ws = p.ws;
    LAS float* red = (LAS float*)(lds + 2048);
    LAS unsigned char* Q = lds + 4096;
    LAS unsigned char* Kt = Q + 17408;
    LAS unsigned char* P = Kt + 17408;
    const int tok0 = c * 64;
    const size_t rowoff = (size_t)(tok0 + tg * 16) * 512 + h * 128 + d;
    const float* bc = (const float*)(ws + WS_BCUM) + rowoff;
    const u16* qp = (const u16*)(ws + WS_ZQ) + rowoff;
    const u16* kp = (const u16*)(ws + WS_ZK) + rowoff;
    float b[16]; u16 qraw[16], kraw[16];
    const int t8 = tid >> 3, dg = (tid & 7) * 16;
    u32x4 qw0, qw1, kw0, kw1, ew0, ew1;
    if (!SMP) {
        const size_t ro = (size_t)(tok0 + t8) * 512 + h * 128 + dg;
        qw0 = *(const u32x4*)((const u16*)(ws + WS_ZQ) + ro); qw1 = *(const u32x4*)((const u16*)(ws + WS_ZQ) + ro + 8);
        kw0 = *(const u32x4*)((const u16*)(ws + WS_ZK) + ro); kw1 = *(const u32x4*)((const u16*)(ws + WS_ZK) + ro + 8);
        ew0 = *(const u32x4*)((const u16*)(ws + WS_BCUM) + ro); ew1 = *(const u32x4*)((const u16*)(ws + WS_BCUM) + ro + 8);
    } else {
#pragma unroll
        for (int i = 0; i < 16; ++i) { qraw[i] = qp[i * 512]; kraw[i] = kp[i * 512]; }
    }
    const u16* vt = (const u16*)(ws + WS_ZVT) + (size_t)(h * 256 + w * 32 + fr) * T + tok0 + fq * 8;
    bf16x8 bv[2][2];
#pragma unroll
    for (int kk = 0; kk < 2; ++kk)
#pragma unroll
        for (int n = 0; n < 2; ++n) bv[kk][n] = *(const bf16x8*)(vt + (size_t)(n * 16) * T + kk * 32);
    const u16* sp = (const u16*)(ws + WS_SP) + (size_t)(c * 4 + h) * 32768 + (size_t)(w * 32 + fr) * 128 + fq * 8;
    bf16x8 bs[4][2];
    if (!SMP) {
#pragma unroll
        for (int kk = 0; kk < 4; ++kk)
#pragma unroll
            for (int n = 0; n < 2; ++n) bs[kk][n] = *(const bf16x8*)(sp + n * 16 * 128 + kk * 32);
    } else {
        const float* s0 = p.state_gla + (((size_t)l * 8 + (c - 256)) * 4 + h) * 32768 + w * 32 + fr;
#pragma unroll
        for (int kk = 0; kk < 4; ++kk)
#pragma unroll
            for (int n = 0; n < 2; ++n) {
                float sv[8];
#pragma unroll
                for (int j = 0; j < 8; ++j) sv[j] = s0[(size_t)(kk * 32 + fq * 8 + j) * 256 + n * 16];
                u32x4 pw; pw.x = cvt_pk_bf16(sv[0], sv[1]); pw.y = cvt_pk_bf16(sv[2], sv[3]); pw.z = cvt_pk_bf16(sv[4], sv[5]); pw.w = cvt_pk_bf16(sv[6], sv[7]);
                bs[kk][n] = __builtin_bit_cast(bf16x8, pw);
            }
    }
    u32x2 gav[4][2];
#pragma unroll
    for (int mt = 0; mt < 4; ++mt)
#pragma unroll
        for (int n = 0; n < 2; ++n) gav[mt][n] = *(const u32x2*)((const u16*)(ws + WS_ZGA) + (size_t)(tok0 + mt * 16 + fr) * 1024 + h * 256 + w * 32 + n * 16 + fq * 4);
    if (SMP) {
        float blast; gla_gates(p, l, h, tok0, d, tg, (LAS float*)lds, b, blast);
#pragma unroll
        for (int i = 0; i < 16; ++i) {
            const int t = tg * 16 + i;
            const float qv = bf2f(qraw[i]) * 0.08838834764831845f * __expf(b[i]);
            const float kv = bf2f(kraw[i]) * __expf(-b[i]);
            ((LAS u16*)Q)[t * 136 + d] = f2bf(qv); ((LAS u16*)Kt)[t * 136 + d] = f2bf(kv);
        }
    } else {
        const unsigned qq[8] = {qw0.x, qw0.y, qw0.z, qw0.w, qw1.x, qw1.y, qw1.z, qw1.w};
        const unsigned kk8[8] = {kw0.x, kw0.y, kw0.z, kw0.w, kw1.x, kw1.y, kw1.z, kw1.w};
        const unsigned ee[8] = {ew0.x, ew0.y, ew0.z, ew0.w, ew1.x, ew1.y, ew1.z, ew1.w};
        unsigned qo[8], ko[8];
#pragma unroll
        for (int j = 0; j < 8; ++j) {
            const float e0 = bflo(ee[j]), e1 = bfhi(ee[j]);
            const float q0 = bflo(qq[j]) * 0.08838834764831845f * e0, q1 = bfhi(qq[j]) * 0.08838834764831845f * e1;
            const float k0 = bflo(kk8[j]) * __builtin_amdgcn_rcpf(e0), k1 = bfhi(kk8[j]) * __builtin_amdgcn_rcpf(e1);
            qo[j] = cvt_pk_bf16(q0, q1); ko[j] = cvt_pk_bf16(k0, k1);
        }
        u32x4 w0, w1; w0.x = qo[0]; w0.y = qo[1]; w0.z = qo[2]; w0.w = qo[3]; w1.x = qo[4]; w1.y = qo[5]; w1.z = qo[6]; w1.w = qo[7];
        *(LAS u32x4*)(Q + t8 * 272 + dg * 2) = w0; *(LAS u32x4*)(Q + t8 * 272 + dg * 2 + 16) = w1;
        w0.x = ko[0]; w0.y = ko[1]; w0.z = ko[2]; w0.w = ko[3]; w1.x = ko[4]; w1.y = ko[5]; w1.z = ko[6]; w1.w = ko[7];
        *(LAS u32x4*)(Kt + t8 * 272 + dg * 2) = w0; *(LAS u32x4*)(Kt + t8 * 272 + dg * 2 + 16) = w1;
    }
    __syncthreads();
    {
        const int mt = w >> 1;
#pragma unroll
        for (int j = 0; j < 2; ++j) {
            const int nt = (w & 1) * 2 + j;
            f32x4 s = (f32x4){0.f, 0.f, 0.f, 0.f};
            if (nt <= mt) {
#pragma unroll
                for (int kk = 0; kk < 4; ++kk) {
                    const bf16x8 a = *(const LAS bf16x8*)(Q + (mt * 16 + fr) * 272 + (kk * 32 + fq * 8) * 2);
                    const bf16x8 bq = *(const LAS bf16x8*)(Kt + (nt * 16 + fr) * 272 + (kk * 32 + fq * 8) * 2);
                    s = __builtin_amdgcn_mfma_f32_16x16x32_bf16(a, bq, s, 0, 0, 0);
                }
            }
#pragma unroll
            for (int e = 0; e < 4; ++e) { const int t = mt * 16 + fq * 4 + e, si = nt * 16 + fr; ((LAS u16*)P)[t * 72 + si] = f2bf(si <= t ? s[e] : 0.f); }
        }
    }
    __syncthreads();
    f32x4 o[4][2];
#pragma unroll
    for (int mt = 0; mt < 4; ++mt) { o[mt][0] = (f32x4){0.f, 0.f, 0.f, 0.f}; o[mt][1] = (f32x4){0.f, 0.f, 0.f, 0.f}; }
#pragma unroll
    for (int kk = 0; kk < 2; ++kk) {
#pragma unroll
        for (int mt = 0; mt < 4; ++mt) {
            if (2 * kk <= mt) {
                const bf16x8 a = *(const LAS bf16x8*)(P + (mt * 16 + fr) * 144 + (kk * 32 + fq * 8) * 2);
#pragma unroll
                for (int n = 0; n < 2; ++n) o[mt][n] = __builtin_amdgcn_mfma_f32_16x16x32_bf16(bv[kk][n], a, o[mt][n], 0, 0, 0);
            }
        }
    }
#pragma unroll
    for (int kk = 0; kk < 4; ++kk) {
#pragma unroll
        for (int mt = 0; mt < 4; ++mt) {
            const bf16x8 a = *(const LAS bf16x8*)(Q + (mt * 16 + fr) * 272 + (kk * 32 + fq * 8) * 2);
#pragma unroll
            for (int n = 0; n < 2; ++n) o[mt][n] = __builtin_amdgcn_mfma_f32_16x16x32_bf16(bs[kk][n], a, o[mt][n], 0, 0, 0);
        }
    }
#pragma unroll
    for (int mt = 0; mt < 4; ++mt) {
        float s2 = 0.f;
#pragma unroll
        for (int n = 0; n < 2; ++n)
#pragma unroll
            for (int e = 0; e < 4; ++e) s2 += o[mt][n][e] * o[mt][n][e];
        s2 += __shfl_xor(s2, 16); s2 += __shfl_xor(s2, 32);
        if (fq == 0) red[w * 64 + mt * 16 + fr] = s2;
    }
    __syncthreads();
    const float* gn = p.gla_norm_g + l * 256 + w * 32 + fq * 4;
    const f32x4 g0 = *(const f32x4*)gn, g1 = *(const f32x4*)(gn + 16);
#pragma unroll
    for (int mt = 0; mt < 4; ++mt) {
        const int t = mt * 16 + fr;
        float tot = 0.f;
#pragma unroll
        for (int ww = 0; ww < 8; ++ww) tot += red[ww * 64 + t];
        const float rs = rsqrtf(tot * (1.f / 256.f) + EPS);
#pragma unroll
        for (int n = 0; n < 2; ++n) {
            const f32x4 gg = n ? g1 : g0; const u32x2 ga = gav[mt][n];
            const float o0 = o[mt][n][0] * rs * gg[0] * silu(bflo(ga.x)), o1 = o[mt][n][1] * rs * gg[1] * silu(bfhi(ga.x));
            const float o2 = o[mt][n][2] * rs * gg[2] * silu(bflo(ga.y)), o3 = o[mt][n][3] * rs * gg[3] * silu(bfhi(ga.y));
            u32x2 wv; wv.x = cvt_pk_bf16(o0, o1); wv.y = cvt_pk_bf16(o2, o3);
            *(u32x2*)((u16*)(ws + WS_OBUF) + (size_t)(tok0 + t) * 2048 + h * 256 + w * 32 + n * 16 + fq * 4) = wv;
        }
    }
    __syncthreads();
}

__device__ __forceinline__ void lr_item(const Params& p, int l, int c, LAS unsigned char* lds) {
    int tid = threadIdx.x; asm volatile("" : "+v"(tid)); asm volatile("" : "+s"(l));
    const int lane = tid & 63, w = tid >> 6, fr = lane & 15, fq = lane >> 4;
    unsigned char* ws = p.ws;
    const u16* xb = (const u16*)(ws + WS_XB) + (size_t)(c * 64) * 2048 + w * 256 + fq * 8;
    const u16* wl = (const u16*)(ws + WS_WTIN) + ((size_t)l * NZROWS + 6144 + fr) * 2048 + w * 256 + fq * 8;
    f32x4 acc[4];
#pragma unroll
    for (int mt = 0; mt < 4; ++mt) acc[mt] = (f32x4){0.f, 0.f, 0.f, 0.f};
#pragma unroll
    for (int kk = 0; kk < 8; ++kk) {
        const bf16x8 bw = *(const bf16x8*)(wl + kk * 32);
#pragma unroll
        for (int mt = 0; mt < 4; ++mt) {
            const bf16x8 a = *(const bf16x8*)(xb + (size_t)(mt * 16 + fr) * 2048 + kk * 32);
            acc[mt] = __builtin_amdgcn_mfma_f32_16x16x32_bf16(a, bw, acc[mt], 0, 0, 0);
        }
    }
    LAS float* red = (LAS float*)lds;
#pragma unroll
    for (int mt = 0; mt < 4; ++mt)
#pragma unroll
        for (int e = 0; e < 4; ++e) red[w * 1024 + (mt * 16 + fq * 4 + e) * 16 + fr] = acc[mt][e];
    __syncthreads();
    {
        const int o = tid * 2, t = o >> 4;
        float s0 = 0.f, s1 = 0.f;
#pragma unroll
        for (int ww = 0; ww < 8; ++ww) { s0 += red[ww * 1024 + o]; s1 += red[ww * 1024 + o + 1]; }
        const float rs = rstd_of(((const u64*)(ws + WS_SUMSQ))[(size_t)l * T + c * 64 + t]);
        float* zl = (float*)(ws + WS_ZLR) + (size_t)(c * 64) * 16 + o;
        zl[0] = s0 * rs; zl[1] = s1 * rs;
    }
    __syncthreads();
}

__device__ __forceinline__ void gla_sample_state_item(const Params& p, int l, int sidx4, LAS unsigned char* lds) {
    int tid = threadIdx.x; asm volatile("" : "+v"(tid)); asm volatile("" : "+s"(l));
    const int lane = tid & 63, wv = tid >> 6, fr = lane & 15, fq = lane >> 4, d = tid & 127, tg = tid >> 7;
    const int s = sidx4 >> 2, h = sidx4 & 3, tok0 = TP + s * 64;
    unsigned char* ws = p.ws;
    LAS float* gs = (LAS float*)(lds + 8192);
    LAS float* dl = (LAS float*)(lds + 8192 + 2048);
    LAS unsigned char* kt = lds + 16384;
    const u16* kp = (const u16*)(ws + WS_ZK) + (size_t)(tok0 + tg * 16) * 512 + h * 128 + d;
    u16 kr[16];
#pragma unroll
    for (int i = 0; i < 16; ++i) kr[i] = kp[i * 512];
    float b[16], blast;
    gla_gates(p, l, h, tok0, d, tg, gs, b, blast);
#pragma unroll
    for (int i = 0; i < 16; ++i) ((LAS u16*)kt)[d * 72 + tg * 16 + i] = f2bf(bf2f(kr[i]) * __expf(blast - b[i]));
    if (tg == 0) dl[d] = __expf(blast);
    __syncthreads();
    const u16* vt = (const u16*)(ws + WS_ZVT) + (size_t)(h * 256 + wv * 32 + fr) * T + tok0 + fq * 8;
    const size_t so_off = (((size_t)l * 8 + s) * 4 + h) * 32768;
    const float* s0 = p.state_gla + so_off;
    float* so = p.out + OFF_GSS + so_off;
#pragma unroll
    for (int n = 0; n < 2; ++n) {
        const bf16x8 v0 = *(const bf16x8*)(vt + (size_t)(n * 16) * T), v1 = *(const bf16x8*)(vt + (size_t)(n * 16) * T + 32);
        const int dv = wv * 32 + n * 16 + fr;
#pragma unroll
        for (int mt = 0; mt < 8; ++mt) {
            f32x4 a = (f32x4){0.f, 0.f, 0.f, 0.f};
            const bf16x8 k0 = *(const LAS bf16x8*)(kt + (mt * 16 + fr) * 144 + (fq * 8) * 2), k1 = *(const LAS bf16x8*)(kt + (mt * 16 + fr) * 144 + (32 + fq * 8) * 2);
            a = __builtin_amdgcn_mfma_f32_16x16x32_bf16(k0, v0, a, 0, 0, 0);
            a = __builtin_amdgcn_mfma_f32_16x16x32_bf16(k1, v1, a, 0, 0, 0);
            const int dk0 = mt * 16 + fq * 4;
#pragma unroll
            for (int e = 0; e < 4; ++e) so[(dk0 + e) * 256 + dv] = dl[dk0 + e] * s0[(dk0 + e) * 256 + dv] + a[e];
        }
    }
    __syncthreads();
}

__device__ __forceinline__ void gmlp_item(const Params& p, int l, int mc, int g, LAS unsigned char* lds) {
    int tid = threadIdx.x; asm volatile("" : "+v"(tid)); asm volatile("" : "+s"(l));
    const int lane = tid & 63, w = tid >> 6, fr = lane & 15, fq = lane >> 4;
    unsigned char* ws = p.ws;
    LAS float* rsum = (LAS float*)lds;
    LAS float* rsq = (LAS float*)(lds + 2048);
    LAS unsigned char* Vn = lds + 4096;
    LAS float* lnp = (LAS float*)(lds + 4096 + 69632);
    lnp[tid] = (tid < 256) ? p.mlp_ln_g[l * 1024 + g * 256 + tid] : p.mlp_ln_b[l * 1024 + g * 256 + tid - 256];
    const bool smp = mc >= 128;
    const int ntok = smp ? 64 : 128, tok0 = smp ? TP + (mc - 128) * 64 : mc * 128;
    const int tk = tid & 127, cq = tid >> 7; const bool active = tk < ntok;
    const int oct = tid & 15, row0 = tid >> 4; const bool act8 = oct * 8 < ntok;
    LAS float* part = (LAS float*)(lds + 77824);
    LAS float* stat = (LAS float*)(lds + 77824 + 8192);
    LAS unsigned char* Wl = lds + 88064;
    {
        const u16* wsrc = (const u16*)(ws + WS_WSB) + (size_t)(l * 4 + g) * 128 * 128;
        u32x4 wt[4];
#pragma unroll
        for (int i = 0; i < 4; ++i) { const int ch = tid + i * 512; wt[i] = *(const u32x4*)(wsrc + (ch >> 4) * 128 + (ch & 15) * 8); }
#pragma unroll
        for (int i = 0; i < 4; ++i) { const int ch = tid + i * 512; *(LAS u32x4*)(Wl + (ch >> 4) * 272 + (ch & 15) * 16) = wt[i]; }
    }
    u32x4 raw[8];
    {
        const u16* vp = (const u16*)(ws + WS_ZVMT) + (size_t)(g * 256 + row0) * T + tok0 + oct * 8;
#pragma unroll
        for (int i = 0; i < 8; ++i) raw[i] = act8 ? *(const u32x4*)(vp + (size_t)(32 * i) * T) : (u32x4){0u, 0u, 0u, 0u};
    }
    {
        float ps[8], pq[8];
#pragma unroll
        for (int j = 0; j < 8; ++j) { ps[j] = 0.f; pq[j] = 0.f; }
#pragma unroll
        for (int i = 0; i < 8; ++i) {
            const float x0 = bflo(raw[i].x), x1 = bfhi(raw[i].x), x2 = bflo(raw[i].y), x3 = bfhi(raw[i].y), x4 = bflo(raw[i].z), x5 = bfhi(raw[i].z), x6 = bflo(raw[i].w), x7 = bfhi(raw[i].w);
            ps[0] += x0; pq[0] += x0 * x0; ps[1] += x1; pq[1] += x1 * x1; ps[2] += x2; pq[2] += x2 * x2; ps[3] += x3; pq[3] += x3 * x3;
            ps[4] += x4; pq[4] += x4 * x4; ps[5] += x5; pq[5] += x5 * x5; ps[6] += x6; pq[6] += x6 * x6; ps[7] += x7; pq[7] += x7 * x7;
        }
#pragma unroll
        for (int j = 0; j < 8; ++j) { ps[j] += __shfl_xor(ps[j], 16); ps[j] += __shfl_xor(ps[j], 32); pq[j] += __shfl_xor(pq[j], 16); pq[j] += __shfl_xor(pq[j], 32); }
        if (lane < 16) {
#pragma unroll
            for (int j = 0; j < 8; ++j) { part[(w * 128 + oct * 8 + j) * 2] = ps[j]; part[(w * 128 + oct * 8 + j) * 2 + 1] = pq[j]; }
        }
    }
    __syncthreads();
    if (tid < 128) {
        float S = 0.f, S2 = 0.f;
#pragma unroll
        for (int ww = 0; ww < 8; ++ww) { S += part[(ww * 128 + tid) * 2]; S2 += part[(ww * 128 + tid) * 2 + 1]; }
        const float mu = S * (1.f / 256.f), var = fmaxf(S2 * (1.f / 256.f) - mu * mu, 0.f);
        stat[tid * 2] = mu; stat[tid * 2 + 1] = rsqrtf(var + EPS);
    }
    __syncthreads();
    {
        float mu[8], rs[8];
#pragma unroll
        for (int j = 0; j < 8; ++j) { mu[j] = stat[(oct * 8 + j) * 2]; rs[j] = stat[(oct * 8 + j) * 2 + 1]; }
        float* mvs = p.out + OFF_MVS + (((size_t)l * 8 + (mc - 128)) * 64 + oct * 8) * 1024 + g * 256;
#pragma unroll
        for (int i = 0; i < 8; ++i) {
            const int c = row0 + 32 * i; const float gg = lnp[c], bb = lnp[256 + c];
            float vn[8];
            vn[0] = (bflo(raw[i].x) - mu[0]) * rs[0] * gg + bb; vn[1] = (bfhi(raw[i].x) - mu[1]) * rs[1] * gg + bb;
            vn[2] = (bflo(raw[i].y) - mu[2]) * rs[2] * gg + bb; vn[3] = (bfhi(raw[i].y) - mu[3]) * rs[3] * gg + bb;
            vn[4] = (bflo(raw[i].z) - mu[4]) * rs[4] * gg + bb; vn[5] = (bfhi(raw[i].z) - mu[5]) * rs[5] * gg + bb;
            vn[6] = (bflo(raw[i].w) - mu[6]) * rs[6] * gg + bb; vn[7] = (bfhi(raw[i].w) - mu[7]) * rs[7] * gg + bb;
            u32x4 wv = (u32x4){0u, 0u, 0u, 0u};
            if (act8) {
                wv.x = cvt_pk_bf16(vn[0], vn[1]); wv.y = cvt_pk_bf16(vn[2], vn[3]); wv.z = cvt_pk_bf16(vn[4], vn[5]); wv.w = cvt_pk_bf16(vn[6], vn[7]);
                if (smp) {
#pragma unroll
                    for (int j = 0; j < 8; ++j) mvs[(size_t)j * 1024 + c] = vn[j];
                }
            }
            *(LAS u32x4*)(Vn + c * 272 + oct * 16) = wv;
        }
    }
    __syncthreads();
    const int ntt = ntok >> 4;
    f32x4 acc[2][8];
#pragma unroll
    for (int tt = 0; tt < 8; ++tt) { acc[0][tt] = (f32x4){0.f, 0.f, 0.f, 0.f}; acc[1][tt] = (f32x4){0.f, 0.f, 0.f, 0.f}; }
#pragma unroll
    for (int kk = 0; kk < 4; ++kk) {
        bf16x8 a[2];
#pragma unroll
        for (int ct = 0; ct < 2; ++ct) a[ct] = *(const LAS bf16x8*)(Vn + (w * 32 + ct * 16 + fr) * 272 + (kk * 32 + fq * 8) * 2);
#pragma unroll
        for (int tt = 0; tt < 8; ++tt) {
            if ((tt >> 1) >= kk && tt < ntt) {
                const bf16x8 bw = *(const LAS bf16x8*)(Wl + (tt * 16 + fr) * 272 + (kk * 32 + fq * 8) * 2);
#pragma unroll
                for (int ct = 0; ct < 2; ++ct) acc[ct][tt] = __builtin_amdgcn_mfma_f32_16x16x32_bf16(a[ct], bw, acc[ct][tt], 0, 0, 0);
            }
        }
    }
    const float* bsp = p.b_s + (size_t)(l * 4 + g) * 128;
#pragma unroll
    for (int tt = 0; tt < 8; ++tt) {
        if (tt < ntt) {
            const int tok = tok0 + tt * 16 + fr; const float bs = bsp[tt * 16 + fr];
#pragma unroll
            for (int ct = 0; ct < 2; ++ct) {
                const int cb = g * 256 + w * 32 + ct * 16 + fq * 4;
                const u32x2 uu = *(const u32x2*)((const u16*)(ws + WS_ZU) + (size_t)tok * 1024 + cb);
                const u32x2 gg = *(const u32x2*)((const u16*)(ws + WS_ZGB) + (size_t)tok * 1024 + cb);
                const float o0 = bflo(uu.x) * (acc[ct][tt][0] + bs) * silu(bflo(gg.x));
                const float o1 = bfhi(uu.x) * (acc[ct][tt][1] + bs) * silu(bfhi(gg.x));
                const float o2 = bflo(uu.y) * (acc[ct][tt][2] + bs) * silu(bflo(gg.y));
                const float o3 = bfhi(uu.y) * (acc[ct][tt][3] + bs) * silu(bfhi(gg.y));
                u32x2 wv; wv.x = cvt_pk_bf16(o0, o1); wv.y = cvt_pk_bf16(o2, o3);
                *(u32x2*)((u16*)(ws + WS_OBUF) + (size_t)tok * 2048 + 1024 + cb) = wv;
            }
        }
    }
    __syncthreads();
}

__device__ __forceinline__ void phase_final(const Params& p) {
    int tid = threadIdx.x; asm volatile("" : "+v"(tid));
    const int lane = tid & 63, wid = tid >> 6;
    const u16* xb = (const u16*)(p.ws + WS_XB);
    const u64* ss = (const u64*)(p.ws + WS_SUMSQ) + (size_t)4 * T;
    for (int row = blockIdx.x * 8 + wid; row < T; row += gridDim.x * 8) {
        const float rs = rstd_of(ss[row]);
#pragma unroll
        for (int j = 0; j < 4; ++j) {
            const u32x4 xw = *(const u32x4*)(xb + (size_t)row * 2048 + j * 512 + lane * 8);
            const f32x4 g0 = *(const f32x4*)(p.final_norm_g + j * 512 + lane * 8), g1 = *(const f32x4*)(p.final_norm_g + j * 512 + lane * 8 + 4);
            float* o = p.out + OFF_Y + (size_t)row * 2048 + j * 512 + lane * 8;
            *(f32x4*)o = (f32x4){bflo(xw.x), bfhi(xw.x), bflo(xw.y), bfhi(xw.y)} * rs * g0;
            *(f32x4*)(o + 4) = (f32x4){bflo(xw.z), bfhi(xw.z), bflo(xw.w), bfhi(xw.w)} * rs * g1;
        }
    }
}

#define XB_TMO      128
#define XB_XCNT(j)  (256  + 64 * (j))
#define XB_XSUB(j)  (1280 + 64 * (j))
#define XB_XGEN(j)  (2304 + 64 * (j))
#define XB_TOP      3328
#define XB_TOPGEN   3392
#define XB_QUEUE    3520
#define XB_SPIN_CAP (1u << 20)
__device__ __forceinline__ unsigned xb_ld(unsigned* p)              { return __hip_atomic_load(p, __ATOMIC_RELAXED, __HIP_MEMORY_SCOPE_AGENT); }
__device__ __forceinline__ unsigned xb_add(unsigned* p, unsigned v) { return __hip_atomic_fetch_add(p, v, __ATOMIC_RELAXED, __HIP_MEMORY_SCOPE_AGENT); }
__device__ __forceinline__ unsigned xb_xcc_id() { return (unsigned)__builtin_amdgcn_s_getreg((3 << 11) | 20) & 0xFu; }
#define XB_SPIN(cond, bar) do { unsigned _sp = 0; while (cond) { __builtin_amdgcn_s_sleep(1); \
    if ((++_sp & 255u) == 0u) { if (xb_ld(&(bar)[XB_TMO])) break; if (_sp > XB_SPIN_CAP) { atomicAdd(&(bar)[XB_TMO], 1u); break; } } } } while (0)
struct XcdBarrier { unsigned* bar; unsigned x; volatile LAS unsigned* st; };
__device__ __forceinline__ void xcd_barrier_complete(unsigned* bar, unsigned x, unsigned& nloc, unsigned& nx) {
    const unsigned G = gridDim.x;
    unsigned sum, cnt, mine, sp = 0u;
    for (;;) {
        sum = 0u; cnt = 0u; mine = 0u;
#pragma unroll
        for (unsigned j = 0; j < 16; ++j) { const unsigned c = xb_ld(&bar[XB_XCNT(j)]); sum += c; cnt += (c > 0u) ? 1u : 0u; mine = (j == x) ? c : mine; }
        if (sum == G) break;
        __builtin_amdgcn_s_sleep(1);
        if ((++sp & 255u) == 0u) { if (xb_ld(&bar[XB_TMO])) break; if (sp > XB_SPIN_CAP) { atomicAdd(&bar[XB_TMO], 1u); break; } }
    }
    nloc = mine > 0u ? mine : 1u; nx = cnt > 0u ? cnt : 1u;
}
__device__ __forceinline__ void grid_barrier(const XcdBarrier& b) {
    asm volatile("s_waitcnt vmcnt(0)" ::: "memory");
    __syncthreads();
    if (threadIdx.x == 0) {
        unsigned* bar = b.bar;
        __builtin_amdgcn_s_waitcnt(0);
        unsigned nloc = b.st[0], nx = b.st[1];
        if (nloc == 0u) { xcd_barrier_complete(bar, b.x, nloc, nx); b.st[0] = nloc; b.st[1] = nx; }
        const unsigned old = xb_add(&bar[XB_XSUB(b.x)], 1u);
        const unsigned gen = old / nloc;
        if (old + 1u == (gen + 1u) * nloc) {
            __builtin_amdgcn_fence(__ATOMIC_RELEASE, "agent");
            asm volatile("s_waitcnt vmcnt(0)" ::: "memory");
            const unsigned og = xb_add(&bar[XB_TOP], 1u);
            const unsigned tg = og / nx;
            if (og + 1u == (tg + 1u) * nx) xb_add(&bar[XB_TOPGEN], 1u);
            else XB_SPIN(xb_ld(&bar[XB_TOPGEN]) == tg, bar);
            __builtin_amdgcn_fence(__ATOMIC_ACQUIRE, "agent");
            xb_add(&bar[XB_XGEN(b.x)], 1u);
            asm volatile("s_waitcnt vmcnt(0)" ::: "memory");
        } else {
            XB_SPIN(xb_ld(&bar[XB_XGEN(b.x)]) == gen, bar);
            __builtin_amdgcn_fence(__ATOMIC_ACQUIRE, "agent");
            asm volatile("s_waitcnt vmcnt(0)" ::: "memory");
        }
    }
    __syncthreads();
}

__device__ __forceinline__ int queue_next(unsigned* ctr, LAS int* slot) {
    __syncthreads();
    if (threadIdx.x == 0) *slot = (int)__hip_atomic_fetch_add(ctr, 1u, __ATOMIC_RELAXED, __HIP_MEMORY_SCOPE_AGENT);
    __syncthreads();
    return *slot;
}

__global__ void __launch_bounds__(NTHREADS) fwd_megakernel(Params p) {
    extern __shared__ __attribute__((aligned(16))) unsigned char lds_raw[];
    LAS unsigned char* lds = (LAS unsigned char*)lds_raw;
    cg::grid_group grid = cg::this_grid();
    unsigned* bar = (unsigned*)(p.ws + WS_BAR);
    LAS int* qslot = (LAS int*)(lds + 131072);
    XcdBarrier xb; xb.bar = bar; xb.x = xb_xcc_id(); xb.st = (volatile LAS unsigned*)(lds + 131072 + 16);
    if (threadIdx.x == 0) { xb.st[0] = 0u; xb.st[1] = 0u; (void)xb_add(&bar[XB_XCNT(xb.x)], 1u); }
    __syncthreads();
    grid.sync();
    phase_prep(p, lds);
    if (PROBE_DUP & 1) { grid_barrier(xb); phase_prep(p, lds); }
    grid_barrier(xb);
#pragma unroll 1
    for (int l = 0; l < DEPTH; ++l) {
        const int bx = blockIdx.x;
        {
            const int grp = (bx >> 3) & 1;
#pragma unroll 1
            for (int pass = 0; pass < 2; ++pass) {
                if (pass == grp) for (int c = bx; c < 256; c += gridDim.x) lr_item(p, l, c, lds);
                if (pass == 0) gemm_phase<0>(lds, p, l, -1);
            }
        }
        grid_barrier(xb);
#pragma unroll 1
        for (int sub = 0; sub < 2; ++sub) {
            int start, hi, step;
            if (sub == 0) {
                if (bx < 48) gemm_phase<0>(lds, p, l, bx);
                else if (bx >= 240 && bx < 248) lr_item(p, l, 256 + bx - 240, lds);
                hi = 832; step = 208; start = (bx < 48) ? hi : bx - 48;
            } else {
                hi = 1024; step = 256; start = (bx >= 48) ? 832 + bx - 48 : hi;
                asm volatile("s_waitcnt vmcnt(0)" ::: "memory");
                __syncthreads();
                if (threadIdx.x == 0) { __builtin_amdgcn_fence(__ATOMIC_ACQUIRE, "agent"); asm volatile("s_waitcnt vmcnt(0)" ::: "memory"); }
                __syncthreads();
            }
            for (int it = start; it < hi; it += step) gla_local_item(p, l, it >> 2, it & 3, lds);
        }
        grid_barrier(xb);
#pragma unroll 1
        for (int sub = 0; sub < 2; ++sub) {
            unsigned* qc = bar + XB_QUEUE + l * 8 + 2;
#pragma unroll 1
            for (int n = 0;; ++n) {
                int code;
                if (sub == 0) {
                    const int q = queue_next(qc, qslot);
                    if (q >= 496) break;
                    code = (q < 64) ? q : (q < 96 ? 608 + (q - 64) : (q < 128 ? 640 + (q - 96) : (q < 160 ? 64 + 512 + (q - 128) : 64 + (q - 160))));
                } else {
                    if (bx < 16) { if (n > 0) break; code = 3000 + bx; }
                    else {
                        const int k = bx - 16;
                        if (n < 4) code = 1000 + k + 240 * n;
                        else if (n == 4) code = (k < 64) ? 1000 + k + 960 : 64 + 336 + (k - 64);
                        else break;
                    }
                }
                if (code < 64) scan_task(p, l, code, lds);
                else if (code < 608) gmlp_item(p, l, (code - 64) >> 2, (code - 64) & 3, lds);
                else if (code < 640) gla_out_item<true>(p, l, 256 + ((code - 608) >> 2), (code - 608) & 3, lds);
                else if (code < 672) gla_sample_state_item(p, l, code - 640, lds);
                else if (code < 3000) gla_out_item<false>(p, l, (code - 1000) >> 2, (code - 1000) & 3, lds);
                else gemm_phase<1>(lds, p, l, code - 3000);
            }
            grid_barrier(xb);
        }
        gemm_phase<1>(lds, p, l, -1);
        grid_barrier(xb);
    }
    phase_final(p);
}

extern "C" void kernel_launch(void* const* d_in, const int* in_sizes, int n_in, void* d_out, int out_size, void* d_ws, size_t ws_size, hipStream_t stream) {
    static int grid = 0;
    if (grid == 0) {
        if (n_in != 14 || ws_size < WS_END) { fprintf(stderr, "kernel_launch: unexpected n_in %d / ws_size %zu (need %zu)\n", n_in, ws_size, (size_t)WS_END); grid = -1; return; }
        int dev = 0, cus = 0, per_cu = 0;
        (void)hipGetDevice(&dev);
        (void)hipDeviceGetAttribute(&cus, hipDeviceAttributeMultiprocessorCount, dev);
        if (hipFuncSetAttribute((const void*)fwd_megakernel, hipFuncAttributeMaxDynamicSharedMemorySize, LDS_BYTES) != hipSuccess) { fprintf(stderr, "kernel_launch: hipFuncSetAttribute failed\n"); grid = -1; return; }
        (void)hipOccupancyMaxActiveBlocksPerMultiprocessor(&per_cu, (const void*)fwd_megakernel, NTHREADS, LDS_BYTES);
        (void)hipGetLastError();
        if (per_cu < 1) { fprintf(stderr, "kernel_launch: occupancy query says %d blocks per CU\n", per_cu); per_cu = 1; }
        grid = cus;
    }
    if (grid < 0) return;
    (void)hipMemsetAsync((unsigned char*)d_ws + WS_BAR, 0, 16384, stream);
    Params p{};
    p.x_prompt = (const float*)d_in[0]; p.x_sample = (const float*)d_in[1]; p.state_gla = (const float*)d_in[2]; p.w_in = (const float*)d_in[3];
    p.w_gate_up = (const float*)d_in[4]; p.b_gate = (const float*)d_in[5]; p.w_s = (const float*)d_in[6]; p.b_s = (const float*)d_in[7];
    p.norm_g = (const float*)d_in[8]; p.gla_norm_g = (const float*)d_in[9]; p.mlp_ln_g = (const float*)d_in[10]; p.mlp_ln_b = (const float*)d_in[11];
    p.w_out = (const float*)d_in[12]; p.final_norm_g = (const float*)d_in[13];
    p.out = (float*)d_out; p.ws = (unsigned char*)d_ws;
    void* args[] = {&p};
    hipError_t e = hipLaunchCooperativeKernel((const void*)fwd_megakernel, dim3(grid), dim3(NTHREADS), args, LDS_BYTES, stream);
    if (e != hipSuccess) fprintf(stderr, "cooperative launch failed: %s (grid %d)\n", hipGetErrorString(e), grid);
}
```
